# Optimizing an MI355X kernel written in HIP

```python
import math
import jax, jax.numpy as jnp
from jax import lax
import numpy as np

D_MODEL = 2048
BATCH = 4
SEQ = 2048
DEPTH = 2
DEC_BATCH = 128
DEC_SEQ = 8
PAST_LEN = 16384
PAGE_SIZE = 128

N_MIXERS = 2
N_MLSTM_LAYERS = (DEPTH + 1) // N_MIXERS
N_RWKV_LAYERS = DEPTH // N_MIXERS
PLE_DIM = 256
D_FF = -(-8 * D_MODEL // (3 * 256)) * 256

MLSTM_HEADS = 8
MLSTM_DQK = D_MODEL // 2 // MLSTM_HEADS
MLSTM_DV = D_MODEL // MLSTM_HEADS
MLSTM_CHUNK = 64
GATE_SOFTCAP = 15.0

RWKV_HEAD_DIM = 64
RWKV_HEADS = D_MODEL // RWKV_HEAD_DIM
DECAY_LORA = 96
AAA_LORA = 96
GATE_LORA = 256

NORM_EPS = 1e-6
RWKV_GN_EPS = 64e-5
L2_EPS = 1e-12

kernel_name = 'mlstm_rwkv7_hybrid_step'


def rms_norm(x, g):
    xf = x.astype(jnp.float32)
    y = xf * lax.rsqrt(jnp.mean(xf * xf, axis=-1, keepdims=True) + NORM_EPS)
    return (y * g.astype(jnp.float32)).astype(x.dtype)


def softcap(x, cap):
    return cap * jnp.tanh(x / cap)


def swiglu(x, w_gate, w_up, w_down):
    return (jax.nn.silu(x @ w_gate) * (x @ w_up)) @ w_down


def mlstm_chunk_step(carry, inp):
    C, n, m = carry
    q, k, v, li, lf = inp
    L = q.shape[2]
    b = jnp.cumsum(lf, axis=-1)
    causal = jnp.tril(jnp.ones((L, L), dtype=bool))
    dlog = jnp.where(causal, b[..., :, None] - b[..., None, :] + li[..., None, :], -jnp.inf)
    a = b + m[..., None]
    m_t = jnp.maximum(a, jnp.max(dlog, axis=-1))
    w_intra = jnp.exp(dlog - m_t[..., None])
    w_inter = jnp.exp(a - m_t)
    s = jnp.einsum('bhtd,bhsd->bhts', q, k) * w_intra
    num = w_inter[..., None] * jnp.einsum('bhtd,bhde->bhte', q, C) + jnp.einsum('bhts,bhse->bhte', s, v)
    den = w_inter * jnp.einsum('bhtd,bhd->bht', q, n) + jnp.sum(s, axis=-1)
    h = num / jnp.maximum(jnp.abs(den), jnp.exp(-m_t))[..., None]
    m_new = m_t[..., -1]
    decay_state = jnp.exp(b[..., -1] + m - m_new)
    w_k = jnp.exp(b[..., -1:] - b + li - m_new[..., None])
    C_new = decay_state[..., None, None] * C + jnp.einsum('bhs,bhsd,bhse->bhde', w_k, k, v)
    n_new = decay_state[..., None] * n + jnp.einsum('bhs,bhsd->bhd', w_k, k)
    return (C_new, n_new, m_new), h


def mlstm_mixer(xn, w_q, w_k, w_v, w_ig, b_ig, w_fg, b_fg, w_og, norm_w, w_out, C0, n0, m0):
    B, T, _ = xn.shape
    H, DK, DV = MLSTM_HEADS, MLSTM_DQK, MLSTM_DV
    f32 = jnp.float32
    q = (xn @ w_q).astype(f32).reshape(B, T, H, DK).transpose(0, 2, 1, 3)
    k = (xn @ w_k).astype(f32).reshape(B, T, H, DK).transpose(0, 2, 1, 3) * (DK ** -0.5)
    v = (xn @ w_v).astype(f32).reshape(B, T, H, DV).transpose(0, 2, 1, 3)
    li = softcap((xn @ w_ig + b_ig).astype(f32), GATE_SOFTCAP).transpose(0, 2, 1)
    lf = jax.nn.log_sigmoid(softcap((xn @ w_fg + b_fg).astype(f32), GATE_SOFTCAP)).transpose(0, 2, 1)
    L = math.gcd(T, MLSTM_CHUNK)
    NC = T // L

    def blocks(t):
        return jnp.moveaxis(t.reshape(B, H, NC, L, *t.shape[3:]), 2, 0)

    carry0 = (C0.astype(f32), n0.astype(f32), m0.astype(f32))
    (C, n, m), h = lax.scan(mlstm_chunk_step, carry0, (blocks(q), blocks(k), blocks(v), blocks(li), blocks(lf)))
    h = jnp.moveaxis(h, 0, 2).reshape(B, H, T, DV).transpose(0, 2, 1, 3)
    h = h * lax.rsqrt(jnp.mean(h * h, axis=-1, keepdims=True) + NORM_EPS)
    h = h.reshape(B, T, H * DV) * norm_w.astype(f32)
    o = jax.nn.sigmoid((xn @ w_og).astype(f32))
    out = (o * h).astype(xn.dtype) @ w_out
    return out, C, n, m


def rwkv7_step(S, inp):
    r, w, k, v, kk, a = inp
    sa = jnp.einsum('bhvk,bhk->bhv', S, -kk)
    S = S * w[:, :, None, :] + sa[..., None] * (kk * a)[:, :, None, :] + v[..., None] * k[:, :, None, :]
    return S, jnp.einsum('bhvk,bhk->bhv', S, r)


def rwkv7_mixer(xn, mu, w_r, w_k, w_v, w_o, w0, w1, w2, a0, a1, a2, g1, g2, k_k, k_a, r_k, ln_w, ln_b, S0, shift0):
    B, T, D = xn.shape
    H, N = RWKV_HEADS, RWKV_HEAD_DIM
    f32 = jnp.float32
    x_prev = jnp.concatenate([shift0[:, None, :].astype(xn.dtype), xn[:, :-1]], axis=1)
    xx = x_prev - xn
    xr, xw, xk, xv, xa, xg = [xn + xx * mu[c] for c in range(6)]
    r = (xr @ w_r).astype(f32)
    k = (xk @ w_k).astype(f32)
    v = (xv @ w_v).astype(f32)
    w_log = -jax.nn.softplus(-(w0 + jnp.tanh(xw @ w1) @ w2).astype(f32)) - 0.5
    decay = jnp.exp(-jnp.exp(w_log))
    a = jax.nn.sigmoid((a0 + (xa @ a1) @ a2).astype(f32))
    g = (jax.nn.sigmoid(xg @ g1) @ g2).astype(f32)
    kk = (k * k_k).reshape(B, T, H, N)
    kk = kk / jnp.maximum(jnp.linalg.norm(kk, axis=-1, keepdims=True), L2_EPS)
    k = k * (1.0 + (a - 1.0) * k_a)

    def heads(t):
        return jnp.moveaxis(t.reshape(B, T, H, N), 1, 0)

    S, y = lax.scan(rwkv7_step, S0.astype(f32),
                    (heads(r), heads(decay), heads(k), heads(v), jnp.moveaxis(kk, 1, 0), heads(a)))
    y = jnp.moveaxis(y, 0, 1)
    mean = jnp.mean(y, axis=-1, keepdims=True)
    var = jnp.mean(jnp.square(y - mean), axis=-1, keepdims=True)
    y = ((y - mean) * lax.rsqrt(var + RWKV_GN_EPS)).reshape(B, T, D) * ln_w + ln_b
    bonus = jnp.sum(r.reshape(B, T, H, N) * k.reshape(B, T, H, N) * r_k, axis=-1, keepdims=True) * v.reshape(B, T, H, N)
    y = y + bonus.reshape(B, T, D)
    out = (y * g).astype(xn.dtype) @ w_o
    return out, S, xn[:, -1]


def trunk(x, p, mC, mn, mm, rS, rshift, w):
    h = x
    new_C, new_n, new_m, new_S, new_shift = [], [], [], [], []
    for i in range(DEPTH):
        j = i // N_MIXERS
        hn = rms_norm(h, w['norm_mix'][i])
        if i % N_MIXERS == 0:
            out, C, n, m = mlstm_mixer(hn, w['mlstm_w_q'][j], w['mlstm_w_k'][j], w['mlstm_w_v'][j],
                                       w['mlstm_w_igate'][j], w['mlstm_b_igate'][j], w['mlstm_w_fgate'][j],
                                       w['mlstm_b_fgate'][j], w['mlstm_w_ogate'][j], w['mlstm_norm_w'][j],
                                       w['mlstm_w_out'][j], mC[j], mn[j], mm[j])
            new_C.append(C)
            new_n.append(n)
            new_m.append(m)
        else:
            out, S, sh = rwkv7_mixer(hn, w['rwkv_mu'][j], w['rwkv_w_r'][j], w['rwkv_w_k'][j], w['rwkv_w_v'][j],
                                     w['rwkv_w_o'][j], w['rwkv_w0'][j], w['rwkv_w1'][j], w['rwkv_w2'][j],
                                     w['rwkv_a0'][j], w['rwkv_a1'][j], w['rwkv_a2'][j], w['rwkv_g1'][j],
                                     w['rwkv_g2'][j], w['rwkv_k_k'][j], w['rwkv_k_a'][j], w['rwkv_r_k'][j],
                                     w['rwkv_ln_w'][j], w['rwkv_ln_b'][j], rS[j], rshift[j])
            new_S.append(S)
            new_shift.append(sh)
        h = h + out
        h = h + swiglu(rms_norm(h, w['norm_ffn'][i]), w['ffn_w_gate'][i], w['ffn_w_up'][i], w['ffn_w_down'][i])
        gate = jax.nn.sigmoid(rms_norm(h, w['norm_ple'][i]) @ w['ple_w_gate'][i])
        h = h + gate * (p[i].astype(h.dtype) @ w['ple_w_proj'][i])
    y = rms_norm(h, w['norm_final'])
    return y, jnp.stack(new_C), jnp.stack(new_n), jnp.stack(new_m), jnp.stack(new_S), jnp.stack(new_shift)


def setup_inputs(seed: int = 0) -> dict:
    key = jax.random.key(seed)
    ks = list(jax.random.split(key, 64))
    f32 = jnp.float32

    def nrm(shape, scale):
        return jax.random.normal(ks.pop(), shape, f32) * scale

    def gain(shape):
        return 1.0 + nrm(shape, 0.02)

    D = D_MODEL
    sd = D ** -0.5
    NM, NR = N_MLSTM_LAYERS, N_RWKV_LAYERS
    H, DK, DV = MLSTM_HEADS, MLSTM_DQK, MLSTM_DV
    RH, RN = RWKV_HEADS, RWKV_HEAD_DIM
    return {
        'x_prompt': nrm((BATCH, SEQ, D), 1.0),
        'x_sample': nrm((DEC_BATCH, DEC_SEQ, D), 1.0),
        'state_mlstm_C': nrm((NM, DEC_BATCH, H, DK, DV), 0.1),
        'state_mlstm_n': nrm((NM, DEC_BATCH, H, DK), 0.1),
        'state_mlstm_m': nrm((NM, DEC_BATCH, H), 1.0),
        'state_rwkv_S': nrm((NR, DEC_BATCH, RH, RN, RN), 0.1),
        'state_rwkv_shift': nrm((NR, DEC_BATCH, D), 1.0),
        'p_prompt': nrm((DEPTH, BATCH, SEQ, PLE_DIM), 1.0),
        'p_sample': nrm((DEPTH, DEC_BATCH, DEC_SEQ, PLE_DIM), 1.0),
        'norm_mix': gain((DEPTH, D)),
        'norm_ffn': gain((DEPTH, D)),
        'norm_ple': gain((DEPTH, D)),
        'norm_final': gain((D,)),
        'ffn_w_gate': nrm((DEPTH, D, D_FF), sd),
        'ffn_w_up': nrm((DEPTH, D, D_FF), sd),
        'ffn_w_down': nrm((DEPTH, D_FF, D), D_FF ** -0.5),
        'ple_w_proj': nrm((DEPTH, PLE_DIM, D), PLE_DIM ** -0.5),
        'ple_w_gate': nrm((DEPTH, D, D), sd),
        'mlstm_w_q': nrm((NM, D, H * DK), sd),
        'mlstm_w_k': nrm((NM, D, H * DK), sd),
        'mlstm_w_v': nrm((NM, D, H * DV), sd),
        'mlstm_w_igate': nrm((NM, D, H), sd),
        'mlstm_b_igate': -1.0 + nrm((NM, H), 0.1),
        'mlstm_w_fgate': nrm((NM, D, H), sd),
        'mlstm_b_fgate': 3.0 + nrm((NM, H), 0.1),
        'mlstm_w_ogate': nrm((NM, D, D), sd),
        'mlstm_norm_w': gain((NM, D)),
        'mlstm_w_out': nrm((NM, D, D), sd),
        'rwkv_mu': jax.random.uniform(ks.pop(), (NR, 6, D), f32),
        'rwkv_w_r': nrm((NR, D, D), sd),
        'rwkv_w_k': nrm((NR, D, D), sd),
        'rwkv_w_v': nrm((NR, D, D), sd),
        'rwkv_w_o': nrm((NR, D, D), sd),
        'rwkv_w0': -6.0 + 5.0 * jax.random.uniform(ks.pop(), (NR, D), f32),
        'rwkv_w1': nrm((NR, D, DECAY_LORA), sd),
        'rwkv_w2': nrm((NR, DECAY_LORA, D), 0.5 * DECAY_LORA ** -0.5),
        'rwkv_a0': nrm((NR, D), 0.1),
        'rwkv_a1': nrm((NR, D, AAA_LORA), sd),
        'rwkv_a2': nrm((NR, AAA_LORA, D), 0.5 * AAA_LORA ** -0.5),
        'rwkv_g1': nrm((NR, D, GATE_LORA), sd),
        'rwkv_g2': nrm((NR, GATE_LORA, D), GATE_LORA ** -0.5),
        'rwkv_k_k': 0.85 + nrm((NR, D), 0.05),
        'rwkv_k_a': 1.0 + nrm((NR, D), 0.05),
        'rwkv_r_k': nrm((NR, RH, RN), 0.1),
        'rwkv_ln_w': gain((NR, D)),
        'rwkv_ln_b': nrm((NR, D), 0.02),
    }


def reference(x_prompt, x_sample, state_mlstm_C, state_mlstm_n, state_mlstm_m, state_rwkv_S, state_rwkv_shift,
              p_prompt, p_sample, norm_mix, norm_ffn, norm_ple, norm_final, ffn_w_gate, ffn_w_up, ffn_w_down,
              ple_w_proj, ple_w_gate, mlstm_w_q, mlstm_w_k, mlstm_w_v, mlstm_w_igate, mlstm_b_igate,
              mlstm_w_fgate, mlstm_b_fgate, mlstm_w_ogate, mlstm_norm_w, mlstm_w_out, rwkv_mu, rwkv_w_r,
              rwkv_w_k, rwkv_w_v, rwkv_w_o, rwkv_w0, rwkv_w1, rwkv_w2, rwkv_a0, rwkv_a1, rwkv_a2, rwkv_g1,
              rwkv_g2, rwkv_k_k, rwkv_k_a, rwkv_r_k, rwkv_ln_w, rwkv_ln_b):
    w = {
        'norm_mix': norm_mix, 'norm_ffn': norm_ffn, 'norm_ple': norm_ple, 'norm_final': norm_final,
        'ffn_w_gate': ffn_w_gate, 'ffn_w_up': ffn_w_up, 'ffn_w_down': ffn_w_down,
        'ple_w_proj': ple_w_proj, 'ple_w_gate': ple_w_gate,
        'mlstm_w_q': mlstm_w_q, 'mlstm_w_k': mlstm_w_k, 'mlstm_w_v': mlstm_w_v,
        'mlstm_w_igate': mlstm_w_igate, 'mlstm_b_igate': mlstm_b_igate,
        'mlstm_w_fgate': mlstm_w_fgate, 'mlstm_b_fgate': mlstm_b_fgate,
        'mlstm_w_ogate': mlstm_w_ogate, 'mlstm_norm_w': mlstm_norm_w, 'mlstm_w_out': mlstm_w_out,
        'rwkv_mu': rwkv_mu, 'rwkv_w_r': rwkv_w_r, 'rwkv_w_k': rwkv_w_k, 'rwkv_w_v': rwkv_w_v,
        'rwkv_w_o': rwkv_w_o, 'rwkv_w0': rwkv_w0, 'rwkv_w1': rwkv_w1, 'rwkv_w2': rwkv_w2,
        'rwkv_a0': rwkv_a0, 'rwkv_a1': rwkv_a1, 'rwkv_a2': rwkv_a2, 'rwkv_g1': rwkv_g1, 'rwkv_g2': rwkv_g2,
        'rwkv_k_k': rwkv_k_k, 'rwkv_k_a': rwkv_k_a, 'rwkv_r_k': rwkv_r_k,
        'rwkv_ln_w': rwkv_ln_w, 'rwkv_ln_b': rwkv_ln_b,
    }
    f32 = jnp.float32
    B = x_prompt.shape[0]
    zC = jnp.zeros((N_MLSTM_LAYERS, B, MLSTM_HEADS, MLSTM_DQK, MLSTM_DV), f32)
    zn = jnp.zeros((N_MLSTM_LAYERS, B, MLSTM_HEADS, MLSTM_DQK), f32)
    zm = jnp.zeros((N_MLSTM_LAYERS, B, MLSTM_HEADS), f32)
    zS = jnp.zeros((N_RWKV_LAYERS, B, RWKV_HEADS, RWKV_HEAD_DIM, RWKV_HEAD_DIM), f32)
    zsh = jnp.zeros((N_RWKV_LAYERS, B, D_MODEL), x_prompt.dtype)
    y_prompt, C_p, n_p, m_p, S_p, shift_p = trunk(x_prompt, p_prompt, zC, zn, zm, zS, zsh, w)
    y_sample, C_s, n_s, m_s, S_s, shift_s = trunk(x_sample, p_sample, state_mlstm_C, state_mlstm_n,
                                                  state_mlstm_m, state_rwkv_S, state_rwkv_shift, w)
    return (y_prompt, y_sample, C_p, n_p, m_p, S_p, shift_p, C_s, n_s, m_s, S_s, shift_s)
```

```cpp
#include <hip/hip_runtime.h>
#include <hip/hip_cooperative_groups.h>
#include <cstdio>
namespace cg = cooperative_groups;

#define LAS __attribute__((address_space(3)))
#define DI __device__ __forceinline__
typedef unsigned short u16;
typedef short bf16x8 __attribute__((ext_vector_type(8)));
typedef float f32x4 __attribute__((ext_vector_type(4)));
typedef float f32x16 __attribute__((ext_vector_type(16)));
typedef unsigned u32x4 __attribute__((ext_vector_type(4)));
typedef unsigned u32x2 __attribute__((ext_vector_type(2)));

constexpr int D = 2048, MT = 9216, MPR = 8192, DFF = 5632;
constexpr float NEPS = 1e-6f;
constexpr int LDS_BYTES = 147456;
constexpr int NPH = 16;

enum { I_XP = 0, I_XS, I_MC, I_MN, I_MM, I_RS, I_RSH, I_PP, I_PS, I_NMIX, I_NFFN, I_NPLE, I_NFIN, I_FG, I_FU, I_FD, I_PWP, I_PWG,
       I_MQ, I_MK, I_MV, I_MIG, I_MBIG, I_MFG, I_MBFG, I_MOG, I_MNW, I_MOUT, I_RMU, I_RWR, I_RWK, I_RWV, I_RWO, I_RW0, I_RW1, I_RW2,
       I_RA0, I_RA1, I_RA2, I_RG1, I_RG2, I_RKK, I_RKA, I_RRK, I_RLNW, I_RLNB, N_IN };

constexpr size_t O_Y = 0;
constexpr size_t O_CP = (size_t)MT * D;
constexpr size_t O_NP = O_CP + 1048576;
constexpr size_t O_MP = O_NP + 4096;
constexpr size_t O_SP = O_MP + 32;
constexpr size_t O_SHP = O_SP + 524288;
constexpr size_t O_CS = O_SHP + 8192;
constexpr size_t O_NS = O_CS + 33554432;
constexpr size_t O_MS = O_NS + 131072;
constexpr size_t O_SS = O_MS + 1024;
constexpr size_t O_SHS = O_SS + 16777216;

constexpr size_t SZ_ACT = (size_t)MT * D * 2;
constexpr size_t SZ_SQ = 2048ull * 2048 * 2;
constexpr size_t SZ_W_GU = 11264ull * 2048 * 2;
constexpr size_t SZ_W_DN = 2048ull * 5632 * 2;
constexpr size_t SZ_W_PP = 2048ull * 256 * 2;
constexpr size_t OFF_W_IN0 = 0;
constexpr size_t OFF_W_OUT0 = OFF_W_IN0 + 6400ull * 2048 * 2;
constexpr size_t OFF_W_GU = OFF_W_OUT0 + SZ_SQ;
constexpr size_t OFF_W_DN = OFF_W_GU + 2 * SZ_W_GU;
constexpr size_t OFF_W_PG = OFF_W_DN + 2 * SZ_W_DN;
constexpr size_t OFF_W_PP = OFF_W_PG + 2 * SZ_SQ;
constexpr size_t OFF_W_IN1 = OFF_W_PP + 2 * SZ_W_PP;
constexpr size_t OFF_W_L2 = OFF_W_IN1 + 6912ull * 2048 * 2;
constexpr size_t OFF_W_OUT1 = OFF_W_L2 + 3 * SZ_W_PP;
constexpr size_t OFF_H = OFF_W_OUT1 + SZ_SQ;
constexpr size_t OFF_PPB = OFF_H + (size_t)MT * D * 4;

constexpr size_t OFF_AP = OFF_PPB + SZ_ACT;
constexpr size_t OFF_SSQ = OFF_AP + 2ull * MT * 256 * 2;
constexpr size_t OFF_LG = OFF_SSQ + 5ull * MT * 4;
constexpr size_t OFF_CNT = OFF_LG + 2ull * MT * 8 * 4;
constexpr size_t OFF_LORA = OFF_CNT + 4096;
constexpr size_t OFF_BIG = OFF_LORA + 3ull * MT * 256 * 2;
constexpr size_t WS_NEED = OFF_BIG + 9 * SZ_ACT;

struct Params { const float* in[N_IN]; float* out; unsigned char* ws; int ph_lo, ph_hi; };
typedef const __attribute__((address_space(4))) Params* PP;
__device__ __forceinline__ PP launder(PP q) { asm volatile("" : "+s"(q)); return q; }

DI unsigned f2bf(float f) { unsigned u = __float_as_uint(f); u += 0x7FFFu + ((u >> 16) & 1u); return u >> 16; }
DI unsigned pk2(float lo, float hi) { return f2bf(lo) | (f2bf(hi) << 16); }
DI float bflo(unsigned w) { return __uint_as_float(w << 16); }
DI float bfhi(unsigned w) { return __uint_as_float(w & 0xFFFF0000u); }
DI unsigned cvt_pk_bf16(float lo, float hi) { unsigned r; asm volatile("v_cvt_pk_bf16_f32 %0, %1, %2" : "=v"(r) : "v"(lo), "v"(hi)); return r; }
DI f32x4 ld_bf16x4(const u16* p) { const u32x2 w = *(const u32x2*)p; return (f32x4){bflo(w.x), bfhi(w.x), bflo(w.y), bfhi(w.y)}; }
DI float sigm(float x) { return 1.0f / (1.0f + __expf(-x)); }
DI float fast_tanh(float x) { return 1.0f - 2.0f / (1.0f + __expf(2.0f * x)); }
DI float softcap15(float x) { return 15.0f * fast_tanh(x * (1.0f / 15.0f)); }
DI float softplus(float z) { return fmaxf(z, 0.f) + __logf(1.0f + __expf(-fabsf(z))); }
DI float wave_sum(float v) {
#pragma unroll
    for (int o = 32; o > 0; o >>= 1) v += __shfl_xor(v, o);
    return v;
}
DI float grp8_sum(float v) { v += __shfl_xor(v, 1); v += __shfl_xor(v, 2); v += __shfl_xor(v, 4); return v; }
DI float dppf(float x, const int ctrl_sel) {
    int xi = __float_as_int(x), r;
    if (ctrl_sel == 0) r = __builtin_amdgcn_update_dpp(0, xi, 0xB1, 0xF, 0xF, true);
    else if (ctrl_sel == 1) r = __builtin_amdgcn_update_dpp(0, xi, 0x4E, 0xF, 0xF, true);
    else r = __builtin_amdgcn_update_dpp(0, xi, 0x141, 0xF, 0xF, true);
    return __int_as_float(r);
}
DI float dpp_sum8(float x) { x += dppf(x, 0); x += dppf(x, 1); x += dppf(x, 2); return x; }
DI int opaque_tid(int wv) { int l = __builtin_amdgcn_mbcnt_hi(~0u, __builtin_amdgcn_mbcnt_lo(~0u, 0u)); asm volatile("" : "+v"(l)); return wv * 64 + l; }
DI int crow(int reg, int h) { return (reg & 3) + 8 * (reg >> 2) + 4 * h; }

namespace pg8 {
constexpr int BM = 256, BK = 64, HALF = 128, HTB = HALF * BK * 2, STAGE_BYTES = 8 * HTB, NXCD = 8, WGM = 8;
DI int lds_byte(int r, int c) { const int st = (r >> 4) * 2 + (c >> 5), rr = r & 15, cc = c & 31, ob = rr * 64 + cc * 2; return st * 1024 + (ob ^ (((ob >> 9) & 1) << 5)); }
DI void stage_rc(int b, int& R, int& C) { const int st = b / 1024, sb = b % 1024, swz = sb ^ (((sb >> 9) & 1) << 5); R = (st >> 1) * 16 + swz / 64; C = (st & 1) * 32 + (swz % 64) / 2; }
DI int perm32(int rho) { const int n = rho >> 4, i = rho & 15; return 8 * (i >> 2) + 4 * n + (i & 3); }

struct Unit { const char* A; const char* B; int pm, pn, g, nt, ks, nsp, tu, rb, hm; };
constexpr int NM = 36;
struct Sub1 { const char* A; const char* B; int nN;
    DI void locate(int& L, int& j, const char*& a, const char*& b, int& n) const { j = 0; a = A; b = B; n = nN; } };
struct SubRwkvIn { const char* A; const char* B;
    DI void locate(int& L, int& j, const char*& a, const char*& b, int& n) const {
        constexpr int n8 = NM * 8;
        if (L < 3 * n8) { j = L / n8; L -= j * n8; n = 8; b = B + (size_t)j * 2048 * D * 2; }
        else { L -= 3 * n8; int q = L / NM; if (q > 2) { q = 2; L = NM; } else L -= q * NM; j = 3 + q; n = 1; b = B + (size_t)(6144 + 256 * q) * D * 2; }
        a = A + (size_t)j * SZ_ACT; } };
struct SubLora2 { const char* LA; const char* LB; const char* PA; const char* PB;
    DI void locate(int& L, int& j, const char*& a, const char*& b, int& n) const {
        constexpr int n8 = NM * 8; int q = L / n8; if (q > 3) { q = 3; L = n8; } else L -= q * n8; j = q; n = 8;
        a = (q < 3) ? LA + (size_t)q * MT * 512 : PA; b = (q < 3) ? LB + (size_t)q * SZ_W_PP : PB; } };
template <class Sub> struct MultiOrder {
    Sub sub; int K, nM, G, c; int Lmax = 1 << 30;
    DI bool next(int i, Unit& u) const { const int L0 = i * G + c; if (L0 >= Lmax) return false; return unit_at(L0, u); }
    DI bool unit_at(int L, Unit& u) const {
        int j, nN; const char* A; const char* B;
        sub.locate(L, j, A, B, nN);
        const int nwg = NM * nN;
        if (L >= nwg) return false;
        int wgid = L; { const int q = nwg / NXCD, r = nwg % NXCD, xcd = wgid % NXCD, off = wgid / NXCD; wgid = (xcd < r ? xcd * (q + 1) : r * (q + 1) + (xcd - r) * q) + off; }
        const int nig = WGM * nN, gid = wgid / nig, fm = gid * WGM, gsz = (NM - fm) < WGM ? (NM - fm) : WGM;
        u.pm = fm + ((wgid % nig) % gsz); u.pn = (wgid % nig) / gsz; u.g = j; u.nt = K / BK; u.ks = 0; u.nsp = 1; u.tu = 0; u.rb = u.pm * 256; u.hm = 0;
        const size_t tstep = (size_t)BM * K * 2;
        u.A = A + (size_t)u.pm * tstep; u.B = B + (size_t)u.pn * tstep;
        return true;
    }
    DI bool finish(f32x4 (&acc)[2][2][4][2], const Unit& u, int wid, int lane) const { return true; }
};
struct SplitOrder {
    const char* A; const char* B; float* part; unsigned* cnt; int K, nsp, G, c;
    DI bool next(int i, Unit& u) const {
        int L = i * G + c; const size_t tstep = (size_t)BM * K * 2;
        if (L < 256) {
            const int wg = (L & 7) * 32 + (L >> 3), fm = (wg >> 6) * 8;
            u.pm = fm + ((wg & 63) & 7); u.pn = (wg & 63) >> 3; u.g = 0; u.nt = K / BK; u.ks = 0; u.nsp = 1; u.tu = 0; u.rb = u.pm * 256; u.hm = 0;
            u.A = A + (size_t)u.pm * tstep; u.B = B + (size_t)u.pn * tstep; return true;
        }
        L -= 256;
        if (nsp < 0) return false;
        if (nsp == 0) {
            if (L >= 64) return false;
            const int tu = L >> 1, hh = L & 1;
            u.pm = 32 + (tu & 3); u.pn = tu >> 2; u.g = 0; u.nt = K / BK; u.ks = 0; u.nsp = 1; u.tu = tu; u.rb = u.pm * 256 + hh * 128; u.hm = 1;
            u.A = A + (size_t)u.rb * K * 2; u.B = B + (size_t)u.pn * tstep; return true;
        }
        if (L >= 32 * nsp) return false;
        const int tu = L / nsp, ks = L - tu * nsp, kc = K / nsp;
        u.pm = 32 + (tu & 3); u.pn = tu >> 2; u.g = 0; u.nt = kc / BK; u.ks = ks; u.nsp = nsp; u.tu = tu; u.rb = u.pm * 256; u.hm = 0;
        u.A = A + (size_t)u.pm * tstep + (size_t)ks * kc * 2; u.B = B + (size_t)u.pn * tstep + (size_t)ks * kc * 2; return true;
    }
    DI bool finish(f32x4 (&acc)[2][2][4][2], const Unit& u, int wid, int lane) const {
        if (u.nsp == 1) return true;
        typedef __attribute__((address_space(1))) unsigned gu32;
        const __amdgpu_buffer_rsrc_t rs = __builtin_amdgcn_make_buffer_rsrc((void*)part, (short)0, 32 * 8 * 8 * 8192 * 4, 0x00020000);
        const unsigned base = (unsigned)(((u.tu * nsp) * 8 + wid) * 8192 + lane * 4) * 4u;
        {
            unsigned q = base + (unsigned)u.ks * (8u * 8192u * 4u);
#pragma unroll
            for (int f = 0; f < 32; ++f) {
                __builtin_amdgcn_raw_buffer_store_b128(__builtin_bit_cast(u32x4, acc[f >> 4][(f >> 3) & 1][(f >> 1) & 3][f & 1]), rs, q, 0, 16);
                q += 1024u;
            }
        }
        asm volatile("s_waitcnt vmcnt(0)" ::: "memory");
        unsigned old = 0;
        if (lane == 0) old = __hip_atomic_fetch_add((gu32*)(cnt + u.tu * 8 + wid), 1u, __ATOMIC_RELAXED, __HIP_MEMORY_SCOPE_AGENT);
        old = (unsigned)__builtin_amdgcn_readfirstlane((int)old);
        if (old != (unsigned)(nsp - 1)) return false;
#pragma unroll
        for (int f = 0; f < 32; ++f) acc[f >> 4][(f >> 3) & 1][(f >> 1) & 3][f & 1] = (f32x4){0.f, 0.f, 0.f, 0.f};
#pragma unroll 1
        for (int sp = 0; sp < nsp; ++sp) {
            unsigned q = base + (unsigned)sp * (8u * 8192u * 4u);
#pragma unroll
            for (int f = 0; f < 32; ++f) {
                acc[f >> 4][(f >> 3) & 1][(f >> 1) & 3][f & 1] += __builtin_bit_cast(f32x4, __builtin_amdgcn_raw_buffer_load_b128(rs, q, 0, 16));
                q += 1024u;
            }
        }
        if (lane == 0) __hip_atomic_store((gu32*)(cnt + u.tu * 8 + wid), 0u, __ATOMIC_RELAXED, __HIP_MEMORY_SCOPE_AGENT);
        return true;
    }
};

template <class Epi, class Sched>
DI void gemm_phase(LAS unsigned char* lds, const int K, const Sched& S, const Epi& E, const int wv) {
    const int tid = opaque_tid(wv), wid = __builtin_amdgcn_readfirstlane(tid >> 6), lane = tid & 63, wr = wid >> 2, wc = wid & 3, fr = lane & 15, fq = lane >> 4;
    unsigned voffA[2], voffB[2];
#pragma unroll
    for (int i = 0; i < 2; ++i) { int R, C; stage_rc(tid * 16 + i * 8192, R, C); const int Rb = (R & ~31) + perm32(R & 31);
        voffA[i] = (unsigned)(R * K + C) * 2u; voffB[i] = (unsigned)(Rb * K + C) * 2u; }
    const size_t kstep = (size_t)(BK * 2);
    const size_t hstep = (size_t)HALF * K * 2;
    const unsigned ldsw = (unsigned)wid * 1024u;
    const int aoff = lds_byte(wr * 64 + fr, fq * 8), boff = lds_byte(wc * 32 + fr, fq * 8);
#define PG8_SA(b, h) (((b) * 2 + (h)) * HTB)
#define PG8_SB(b, h) ((4 + (b) * 2 + (h)) * HTB)
#define PG8_STAGE(bufoff, gbase, voff) do { _Pragma("unroll") for (int _i = 0; _i < 2; ++_i) \
        __builtin_amdgcn_global_load_lds((const unsigned*)((const char*)(gbase) + (voff)[_i]), (LAS unsigned*)(lds + (bufoff) + ldsw + _i * 8192), 16, 0, 0); } while (0)
#define PG8_LDA(dst, b, h) do { _Pragma("unroll") for (int m = 0; m < 4; ++m) _Pragma("unroll") for (int k = 0; k < 2; ++k) dst[m][k] = *(const LAS bf16x8*)(lds + PG8_SA(b, h) + aoff + m * 2048 + k * 1024); } while (0)
#define PG8_LDB(dst, b, h) do { _Pragma("unroll") for (int n = 0; n < 2; ++n) _Pragma("unroll") for (int k = 0; k < 2; ++k) dst[n][k] = *(const LAS bf16x8*)(lds + PG8_SB(b, h) + boff + n * 2048 + k * 1024); } while (0)
#define PG8_MMA(ai, bj, At, Bt) do { __builtin_amdgcn_s_setprio(1); _Pragma("unroll") for (int m = 0; m < 4; ++m) _Pragma("unroll") for (int n = 0; n < 2; ++n) _Pragma("unroll") for (int k = 0; k < 2; ++k) \
        acc[ai][bj][m][n] = __builtin_amdgcn_mfma_f32_16x16x32_bf16(Bt[n][k], At[m][k], acc[ai][bj][m][n], 0, 0, 0); __builtin_amdgcn_s_setprio(0); } while (0)
#define PG8_WAIT_V(n) asm volatile("s_waitcnt vmcnt(" #n ")" ::: "memory")
#define PG8_WAIT_L(n) asm volatile("s_waitcnt lgkmcnt(" #n ")" ::: "memory")
#define PG8_BAR __builtin_amdgcn_s_barrier()
#define PG8_SCHED __builtin_amdgcn_sched_barrier(0)
    Unit cur, nxt; int ui = 0;
    if (!S.next(0, cur)) return;
    f32x4 acc[2][2][4][2];
#pragma unroll
    for (int a = 0; a < 2; ++a)
#pragma unroll
        for (int b = 0; b < 2; ++b)
#pragma unroll
            for (int m = 0; m < 4; ++m)
#pragma unroll
                for (int n = 0; n < 2; ++n) acc[a][b][m][n] = (f32x4){0.f, 0.f, 0.f, 0.f};
    bf16x8 At[4][2], B0[2][2], B1[2][2];
    const char* cA = cur.A; const char* cB = cur.B;
    PG8_STAGE(PG8_SB(0, 0), cB, voffB); PG8_STAGE(PG8_SA(0, 0), cA, voffA); PG8_STAGE(PG8_SB(0, 1), cB + hstep, voffB); PG8_STAGE(PG8_SA(0, 1), cA + hstep, voffA);
    if (wr == 1) PG8_BAR;
    PG8_WAIT_V(4); PG8_BAR;
    PG8_STAGE(PG8_SB(1, 0), cB + kstep, voffB); PG8_STAGE(PG8_SA(1, 0), cA + kstep, voffA); PG8_STAGE(PG8_SB(1, 1), cB + hstep + kstep, voffB);
    PG8_WAIT_V(6); PG8_BAR;
    for (;;) {
        const bool has_next = S.next(ui + 1, nxt);
        const char* nA = has_next ? nxt.A : cA; const char* nB = has_next ? nxt.B : cB;
        const int nt = cur.nt; constexpr bool hm = false;
        for (int t = 0; t < nt; t += 2) {
            const bool last = (t == nt - 2);
            const char* a1 = cA + (size_t)(t + 1) * kstep;
            const char* a2 = last ? nA : cA + (size_t)(t + 2) * kstep; const char* b2 = last ? nB : cB + (size_t)(t + 2) * kstep;
            const char* a3 = a2 + kstep; const char* b3 = b2 + kstep;
            PG8_LDB(B0, 0, 0); PG8_SCHED; PG8_LDA(At, 0, 0); PG8_STAGE(PG8_SA(1, 1), a1 + hstep, voffA);
            PG8_WAIT_L(8); PG8_BAR; PG8_WAIT_L(0); PG8_MMA(0, 0, At, B0); PG8_BAR; PG8_SCHED;
            PG8_LDB(B1, 0, 1); PG8_STAGE(PG8_SB(0, 0), b2, voffB);
            PG8_BAR; PG8_WAIT_L(0); PG8_MMA(0, 1, At, B1); PG8_BAR;
            PG8_LDA(At, 0, 1); PG8_STAGE(PG8_SA(0, 0), a2, voffA);
            PG8_BAR; PG8_WAIT_L(0); if (!hm) PG8_MMA(1, 0, At, B0); PG8_BAR; PG8_SCHED;
            PG8_STAGE(PG8_SB(0, 1), b2 + hstep, voffB);
            PG8_WAIT_V(6); PG8_BAR; if (!hm) PG8_MMA(1, 1, At, B1); PG8_BAR;
            PG8_LDB(B0, 1, 0); PG8_SCHED; PG8_LDA(At, 1, 0); PG8_STAGE(PG8_SA(0, 1), a2 + hstep, voffA);
            PG8_WAIT_L(8); PG8_BAR; PG8_WAIT_L(0); PG8_MMA(0, 0, At, B0); PG8_BAR; PG8_SCHED;
            PG8_LDB(B1, 1, 1); PG8_STAGE(PG8_SB(1, 0), b3, voffB);
            PG8_BAR; PG8_WAIT_L(0); PG8_MMA(0, 1, At, B1); PG8_BAR;
            PG8_LDA(At, 1, 1); PG8_STAGE(PG8_SA(1, 0), a3, voffA);
            PG8_BAR; PG8_WAIT_L(0); if (!hm) PG8_MMA(1, 0, At, B0); PG8_BAR; PG8_SCHED;
            PG8_STAGE(PG8_SB(1, 1), b3 + hstep, voffB);
            PG8_WAIT_V(6); PG8_BAR; if (!hm) PG8_MMA(1, 1, At, B1); PG8_BAR;
        }
        if (S.finish(acc, cur, wid, lane)) E(acc, cur, wr, wc, fr, fq);
        if (!has_next) break;
#pragma unroll
        for (int a = 0; a < 2; ++a)
#pragma unroll
            for (int b = 0; b < 2; ++b)
#pragma unroll
                for (int m = 0; m < 4; ++m)
#pragma unroll
                    for (int n = 0; n < 2; ++n) acc[a][b][m][n] = (f32x4){0.f, 0.f, 0.f, 0.f};
        cur = nxt; cA = nA; cB = nB; ++ui;
    }
    PG8_WAIT_V(0);
    if (wr == 0) PG8_BAR;
    PG8_BAR;
#undef PG8_SA
#undef PG8_SB
#undef PG8_STAGE
#undef PG8_LDA
#undef PG8_LDB
#undef PG8_MMA
#undef PG8_WAIT_V
#undef PG8_WAIT_L
#undef PG8_BAR
#undef PG8_SCHED
}
}
using pg8::Unit;
typedef f32x4 AccT[2][2][4][2];

DI void st_bf16x8(u16* p, const f32x4 v0, const f32x4 v1) {
    u32x4 w; w.x = cvt_pk_bf16(v0[0], v0[1]); w.y = cvt_pk_bf16(v0[2], v0[3]); w.z = cvt_pk_bf16(v1[0], v1[1]); w.w = cvt_pk_bf16(v1[2], v1[3]);
    *(u32x4*)p = w;
}

struct EpiMlstmIn {
    u16 *qb, *kb, *vb, *ob; float *li, *lf; const float *big, *bfg;
    DI void operator()(const AccT& acc, const Unit& u, int wr, int wc, int fr, int fq) const {
        const int row0 = u.pm * 256 + wr * 64 + fr, ct = u.pn * 256;
#pragma unroll
        for (int ai = 0; ai < 2; ++ai)
#pragma unroll
            for (int m = 0; m < 4; ++m) {
                const size_t row = (size_t)(row0 + ai * 128 + m * 16);
#pragma unroll
                for (int bj = 0; bj < 2; ++bj) {
                    const int col = ct + bj * 128 + wc * 32 + 8 * fq;
                    f32x4 v0 = acc[ai][bj][m][0], v1 = acc[ai][bj][m][1];
                    if (ct < 1024) st_bf16x8(qb + row * 1024 + col, v0, v1);
                    else if (ct < 2048) st_bf16x8(kb + row * 1024 + (col - 1024), v0 * 0.08838834764831845f, v1 * 0.08838834764831845f);
                    else if (ct < 4096) st_bf16x8(vb + row * 2048 + (col - 2048), v0, v1);
                    else if (ct < 6144) {
#pragma unroll
                        for (int j = 0; j < 4; ++j) { v0[j] = sigm(v0[j]); v1[j] = sigm(v1[j]); }
                        st_bf16x8(ob + row * 2048 + (col - 4096), v0, v1);
                    } else if (col == 6144) {
                        f32x4 a, b;
#pragma unroll
                        for (int j = 0; j < 4; ++j) { a[j] = softcap15(v0[j] + big[j]); b[j] = softcap15(v1[j] + big[4 + j]); }
                        *(f32x4*)(li + row * 8) = a; *(f32x4*)(li + row * 8 + 4) = b;
                    } else if (col == 6152) {
                        f32x4 a, b;
#pragma unroll
                        for (int j = 0; j < 4; ++j) { const float x0 = softcap15(v0[j] + bfg[j]), x1 = softcap15(v1[j] + bfg[4 + j]); a[j] = -softplus(-x0); b[j] = -softplus(-x1); }
                        *(f32x4*)(lf + row * 8) = a; *(f32x4*)(lf + row * 8 + 4) = b;
                    }
                }
            }
    }
};

struct EpiResid {
    u16* h; float* ssq; const float* gamma; u16* An;
    DI void operator()(const AccT& acc, const Unit& u, int wr, int wc, int fr, int fq) const {
        const int row0 = u.rb + wr * 64 + fr, ct = u.pn * 256;
#pragma unroll
        for (int ai = 0; ai < 2; ++ai)
#pragma unroll
            for (int m = 0; m < 4; ++m) {
                if (ai == 1 && u.hm) continue;
                const size_t row = (size_t)(row0 + ai * 128 + m * 16);
                float sq = 0.f;
#pragma unroll
                for (int bj = 0; bj < 2; ++bj) {
                    const int col = ct + bj * 128 + wc * 32 + 8 * fq;
                    u16* hp = h + row * D + col;
                    const u32x4 hw = *(const u32x4*)hp;
                    f32x4 h0 = (f32x4){bflo(hw.x), bfhi(hw.x), bflo(hw.y), bfhi(hw.y)} + acc[ai][bj][m][0], h1 = (f32x4){bflo(hw.z), bfhi(hw.z), bflo(hw.w), bfhi(hw.w)} + acc[ai][bj][m][1];
                    st_bf16x8(hp, h0, h1);
                    sq += h0[0] * h0[0] + h0[1] * h0[1] + h0[2] * h0[2] + h0[3] * h0[3] + h1[0] * h1[0] + h1[1] * h1[1] + h1[2] * h1[2] + h1[3] * h1[3];
                    const f32x4 g0 = *(const f32x4*)(gamma + col), g1 = *(const f32x4*)(gamma + col + 4);
                    st_bf16x8(An + row * D + col, h0 * g0, h1 * g1);
                }
                sq += __shfl_xor(sq, 16); sq += __shfl_xor(sq, 32);
                if (fq == 0) atomicAdd(ssq + row, sq);
            }
    }
};

struct EpiSwiglu {
    const float* ssq; u16* act;
    DI void operator()(const AccT& acc, const Unit& u, int wr, int wc, int fr, int fq) const {
        const int row0 = u.pm * 256 + wr * 64 + fr; const int col = u.pn * 128 + wc * 32 + 8 * fq;
#pragma unroll
        for (int ai = 0; ai < 2; ++ai)
#pragma unroll
            for (int m = 0; m < 4; ++m) {
                const size_t row = (size_t)(row0 + ai * 128 + m * 16);
                const float s = rsqrtf(ssq[row] * (1.0f / D) + NEPS);
                f32x4 o0, o1;
#pragma unroll
                for (int j = 0; j < 4; ++j) {
                    const float g0 = acc[ai][0][m][0][j] * s, u0 = acc[ai][1][m][0][j] * s, g1 = acc[ai][0][m][1][j] * s, u1 = acc[ai][1][m][1][j] * s;
                    o0[j] = g0 * sigm(g0) * u0; o1[j] = g1 * sigm(g1) * u1;
                }
                st_bf16x8(act + row * DFF + col, o0, o1);
            }
    }
};

struct EpiPle {
    const float* ssq_in; const u16* pp; u16* h; float* ssq_out;
    DI void operator()(const AccT& acc, const Unit& u, int wr, int wc, int fr, int fq) const {
        const int row0 = u.rb + wr * 64 + fr, ct = u.pn * 256;
#pragma unroll
        for (int ai = 0; ai < 2; ++ai)
#pragma unroll
            for (int m = 0; m < 4; ++m) {
                if (ai == 1 && u.hm) continue;
                const size_t row = (size_t)(row0 + ai * 128 + m * 16);
                const float s = rsqrtf(ssq_in[row] * (1.0f / D) + NEPS);
                float sq = 0.f;
#pragma unroll
                for (int bj = 0; bj < 2; ++bj) {
                    const int col = ct + bj * 128 + wc * 32 + 8 * fq;
                    u16* hp = h + row * D + col;
                    const u32x4 pw = *(const u32x4*)(pp + row * D + col);
                    const u32x4 hw = *(const u32x4*)hp;
                    f32x4 h0 = (f32x4){bflo(hw.x), bfhi(hw.x), bflo(hw.y), bfhi(hw.y)}, h1 = (f32x4){bflo(hw.z), bfhi(hw.z), bflo(hw.w), bfhi(hw.w)};
                    const f32x4 a0 = acc[ai][bj][m][0], a1 = acc[ai][bj][m][1];
                    h0[0] += sigm(a0[0] * s) * bflo(pw.x); h0[1] += sigm(a0[1] * s) * bfhi(pw.x); h0[2] += sigm(a0[2] * s) * bflo(pw.y); h0[3] += sigm(a0[3] * s) * bfhi(pw.y);
                    h1[0] += sigm(a1[0] * s) * bflo(pw.z); h1[1] += sigm(a1[1] * s) * bfhi(pw.z); h1[2] += sigm(a1[2] * s) * bflo(pw.w); h1[3] += sigm(a1[3] * s) * bfhi(pw.w);
                    st_bf16x8(hp, h0, h1);
                    sq += h0[0] * h0[0] + h0[1] * h0[1] + h0[2] * h0[2] + h0[3] * h0[3] + h1[0] * h1[0] + h1[1] * h1[1] + h1[2] * h1[2] + h1[3] * h1[3];
                }
                if (ssq_out) { sq += __shfl_xor(sq, 16); sq += __shfl_xor(sq, 32); if (fq == 0) atomicAdd(ssq_out + row, sq); }
            }
    }
};

struct EpiRwkvIn {
    u16* rkv; u16* lora;
    DI void operator()(const AccT& acc, const Unit& u, int wr, int wc, int fr, int fq) const {
        const int row0 = u.pm * 256 + wr * 64 + fr, ct = u.pn * 256, g = u.g;
#pragma unroll
        for (int ai = 0; ai < 2; ++ai)
#pragma unroll
            for (int m = 0; m < 4; ++m) {
                const size_t row = (size_t)(row0 + ai * 128 + m * 16);
#pragma unroll
                for (int bj = 0; bj < 2; ++bj) {
                    const int col = ct + bj * 128 + wc * 32 + 8 * fq;
                    f32x4 v0 = acc[ai][bj][m][0], v1 = acc[ai][bj][m][1];
                    if (g < 3) st_bf16x8(rkv + (size_t)g * MT * D + row * D + col, v0, v1);
                    else {
                        if (g == 3) {
#pragma unroll
                            for (int j = 0; j < 4; ++j) { v0[j] = fast_tanh(v0[j]); v1[j] = fast_tanh(v1[j]); }
                        } else if (g == 5) {
#pragma unroll
                            for (int j = 0; j < 4; ++j) { v0[j] = sigm(v0[j]); v1[j] = sigm(v1[j]); }
                        }
                        if (g != 5 && col >= 96) { v0 = (f32x4){0.f, 0.f, 0.f, 0.f}; v1 = v0; }
                        st_bf16x8(lora + (size_t)(g - 3) * MT * 256 + row * 256 + col, v0, v1);
                    }
                }
            }
    }
};

struct EpiLora2 {
    float* wbuf; float* abuf; u16* gbuf; u16* ppb; const float* w0; const float* a0; int gbase;
    DI void operator()(const AccT& acc, const Unit& u, int wr, int wc, int fr, int fq) const {
        const int row0 = u.pm * 256 + wr * 64 + fr, ct = u.pn * 256, g = u.g + gbase;
#pragma unroll
        for (int ai = 0; ai < 2; ++ai)
#pragma unroll
            for (int m = 0; m < 4; ++m) {
                const size_t row = (size_t)(row0 + ai * 128 + m * 16);
#pragma unroll
                for (int bj = 0; bj < 2; ++bj) {
                    const int col = ct + bj * 128 + wc * 32 + 8 * fq;
                    f32x4 v0 = acc[ai][bj][m][0], v1 = acc[ai][bj][m][1];
                    if (g < 2) {
                        const float* bias = g ? a0 : w0; float* dst = g ? abuf : wbuf;
                        const f32x4 b0 = *(const f32x4*)(bias + col), b1 = *(const f32x4*)(bias + col + 4);
                        if (g == 0) { *(f32x4*)(dst + row * D + col) = v0 + b0; *(f32x4*)(dst + row * D + col + 4) = v1 + b1; }
                        else st_bf16x8((u16*)abuf + row * D + col, v0 + b0, v1 + b1);
                    } else if (g == 2) st_bf16x8(gbuf + row * D + col, v0, v1);
                    else st_bf16x8(ppb + row * D + col, v0, v1);
                }
            }
    }
};

struct EpiResidS {
    u16* h; float* ssq; const float* gamma; u16* An;
    DI void operator()(const f32x16& acc, const int row, const int cb, const int half) const {
        float sq = 0.f;
#pragma unroll
        for (int g = 0; g < 4; ++g) {
            const int col = cb + 8 * g; u16* hp = h + (size_t)row * D + col;
            const u32x2 hw = *(const u32x2*)hp;
            const f32x4 hv = (f32x4){bflo(hw.x) + acc[4 * g], bfhi(hw.x) + acc[4 * g + 1], bflo(hw.y) + acc[4 * g + 2], bfhi(hw.y) + acc[4 * g + 3]};
            u32x2 o; o.x = pk2(hv[0], hv[1]); o.y = pk2(hv[2], hv[3]); *(u32x2*)hp = o;
            sq += hv[0] * hv[0] + hv[1] * hv[1] + hv[2] * hv[2] + hv[3] * hv[3];
            const f32x4 g4 = *(const f32x4*)(gamma + col);
            u32x2 a; a.x = pk2(hv[0] * g4[0], hv[1] * g4[1]); a.y = pk2(hv[2] * g4[2], hv[3] * g4[3]); *(u32x2*)(An + (size_t)row * D + col) = a;
        }
        sq += __shfl_xor(sq, 32);
        if (half == 0) atomicAdd(ssq + row, sq);
    }
};
struct EpiPleS {
    const float* ssq_in; const u16* pp; u16* h; float* ssq_out;
    DI void operator()(const f32x16& acc, const int row, const int cb, const int half) const {
        const float s = rsqrtf(ssq_in[row] * (1.0f / D) + NEPS);
        float sq = 0.f;
#pragma unroll
        for (int g = 0; g < 4; ++g) {
            const int col = cb + 8 * g; u16* hp = h + (size_t)row * D + col;
            const u32x2 hw = *(const u32x2*)hp, pw = *(const u32x2*)(pp + (size_t)row * D + col);
            f32x4 hv;
            hv[0] = bflo(hw.x) + sigm(acc[4 * g] * s) * bflo(pw.x); hv[1] = bfhi(hw.x) + sigm(acc[4 * g + 1] * s) * bfhi(pw.x);
            hv[2] = bflo(hw.y) + sigm(acc[4 * g + 2] * s) * bflo(pw.y); hv[3] = bfhi(hw.y) + sigm(acc[4 * g + 3] * s) * bfhi(pw.y);
            u32x2 o; o.x = pk2(hv[0], hv[1]); o.y = pk2(hv[2], hv[3]); *(u32x2*)hp = o;
            sq += hv[0] * hv[0] + hv[1] * hv[1] + hv[2] * hv[2] + hv[3] * hv[3];
        }
        if (ssq_out) { sq += __shfl_xor(sq, 32); if (half == 0) atomicAdd(ssq_out + row, sq); }
    }
};
template <class Epi>
DI void sgemm_sample(LAS unsigned char* lds, const u16* __restrict__ A, const u16* __restrict__ Bt, const int K, const Epi& E, const int wv) {
    const int tid = opaque_tid(wv), wid = tid >> 6, lane = tid & 63, l32 = lane & 31, half = lane >> 5, wm = wid >> 1, wn = wid & 1;
    LAS u16* As = (LAS u16*)lds;
    LAS u16* Bs = (LAS u16*)(lds + 69632);
    const int nk = K / 128;
    const int ar = tid >> 4, kc = (tid & 15) * 8;
    for (int tile = blockIdx.x; tile < 256; tile += gridDim.x) {
        const int row0 = (tile >> 5) * 128, col0 = (tile & 31) * 64;
        f32x16 acc;
#pragma unroll
        for (int j = 0; j < 16; ++j) acc[j] = 0.f;
        const u16* ap = A + (size_t)(row0 + ar) * K + kc; const u16* bp = Bt + (size_t)(col0 + ar) * K + kc;
        const size_t r32 = (size_t)32 * K;
#define SG_LOAD(x, step) do { x##0 = *(const u32x4*)(ap + (step) * 128); x##1 = *(const u32x4*)(ap + r32 + (step) * 128); x##2 = *(const u32x4*)(ap + 2 * r32 + (step) * 128); x##3 = *(const u32x4*)(ap + 3 * r32 + (step) * 128); \
        x##4 = *(const u32x4*)(bp + (step) * 128); x##5 = *(const u32x4*)(bp + r32 + (step) * 128); } while (0)
#define SG_STORE(x, buf) do { LAS u16* a_ = As + (buf) * (128 * 136) + ar * 136 + kc; LAS u16* b_ = Bs + (buf) * (64 * 136) + ar * 136 + kc; \
        *(LAS u32x4*)(a_) = x##0; *(LAS u32x4*)(a_ + 32 * 136) = x##1; *(LAS u32x4*)(a_ + 64 * 136) = x##2; *(LAS u32x4*)(a_ + 96 * 136) = x##3; *(LAS u32x4*)(b_) = x##4; *(LAS u32x4*)(b_ + 32 * 136) = x##5; } while (0)
#define SG_COMPUTE(buf) do { const LAS u16* as = As + (buf) * (128 * 136) + (wm * 32 + l32) * 136 + 8 * half; const LAS u16* bs = Bs + (buf) * (64 * 136) + (wn * 32 + l32) * 136 + 8 * half; \
        _Pragma("unroll") for (int ks = 0; ks < 8; ++ks) { const bf16x8 af = *(const LAS bf16x8*)(as + 16 * ks), bf = *(const LAS bf16x8*)(bs + 16 * ks); acc = __builtin_amdgcn_mfma_f32_32x32x16_bf16(bf, af, acc, 0, 0, 0); } } while (0)
        u32x4 p0, p1, p2, p3, p4, p5, q0, q1, q2, q3, q4, q5;
        SG_LOAD(p, 0); SG_STORE(p, 0); SG_LOAD(p, 1); SG_LOAD(q, 2);
        __syncthreads();
        for (int kt = 0; kt < nk; kt += 2) {
            SG_COMPUTE(0); SG_STORE(p, 1); if (kt + 3 < nk) SG_LOAD(p, kt + 3);
            __syncthreads();
            SG_COMPUTE(1); if (kt + 2 < nk) SG_STORE(q, 0); if (kt + 4 < nk) SG_LOAD(q, kt + 4);
            __syncthreads();
        }
#undef SG_LOAD
#undef SG_STORE
#undef SG_COMPUTE
        E(acc, MPR + row0 + wm * 32 + l32, col0 + wn * 32 + 4 * half, half);
    }
}

DI void sgemm_swiglu_tile(LAS unsigned char* lds, const u16* __restrict__ A, const u16* __restrict__ Wgu, const float* __restrict__ ssq, u16* __restrict__ act, const int wv, const int row0, const int c0) {
    const int tid = opaque_tid(wv), wid = tid >> 6, lane = tid & 63, l32 = lane & 31, half = lane >> 5, wm = wid >> 1, wn = wid & 1;
    LAS u16* As = (LAS u16*)lds;
    LAS u16* Bs = (LAS u16*)(lds + 36864);
    const int K = D, nk = K / 64;
    const int ar = tid >> 3, kc = (tid & 7) * 8;
    {
        const int brow = (c0 >> 7) * 256 + (c0 & 127);
        f32x16 ag, au;
#pragma unroll
        for (int j = 0; j < 16; ++j) { ag[j] = 0.f; au[j] = 0.f; }
        const u16* ap0 = A + (size_t)(row0 + ar) * K + kc; const u16* ap1 = ap0 + (size_t)64 * K;
        const u16* bp0 = Wgu + (size_t)(brow + ar) * K + kc; const u16* bp1 = bp0 + (size_t)128 * K;
#define SW_LOAD(x, step) do { x##0 = *(const u32x4*)(ap0 + (step) * 64); x##1 = *(const u32x4*)(ap1 + (step) * 64); x##2 = *(const u32x4*)(bp0 + (step) * 64); x##3 = *(const u32x4*)(bp1 + (step) * 64); } while (0)
#define SW_STORE(x, buf) do { *(LAS u32x4*)(As + (buf) * (128 * 72) + ar * 72 + kc) = x##0; *(LAS u32x4*)(As + (buf) * (128 * 72) + (ar + 64) * 72 + kc) = x##1; \
        *(LAS u32x4*)(Bs + (buf) * (128 * 72) + ar * 72 + kc) = x##2; *(LAS u32x4*)(Bs + (buf) * (128 * 72) + (ar + 64) * 72 + kc) = x##3; } while (0)
#define SW_COMPUTE(buf) do { const LAS u16* as = As + (buf) * (128 * 72) + (wm * 32 + l32) * 72 + 8 * half; const LAS u16* bs = Bs + (buf) * (128 * 72) + (wn * 32 + l32) * 72 + 8 * half; \
        _Pragma("unroll") for (int ks = 0; ks < 4; ++ks) { const bf16x8 af = *(const LAS bf16x8*)(as + 16 * ks), bg = *(const LAS bf16x8*)(bs + 16 * ks), bu = *(const LAS bf16x8*)(bs + 64 * 72 + 16 * ks); \
            ag = __builtin_amdgcn_mfma_f32_32x32x16_bf16(bg, af, ag, 0, 0, 0); au = __builtin_amdgcn_mfma_f32_32x32x16_bf16(bu, af, au, 0, 0, 0); } } while (0)
        u32x4 p0, p1, p2, p3, q0, q1, q2, q3;
        SW_LOAD(p, 0); SW_STORE(p, 0); SW_LOAD(p, 1); SW_LOAD(q, 2);
        __syncthreads();
        for (int kt = 0; kt < nk; kt += 2) {
            SW_COMPUTE(0); SW_STORE(p, 1); if (kt + 3 < nk) SW_LOAD(p, kt + 3);
            __syncthreads();
            SW_COMPUTE(1); if (kt + 2 < nk) SW_STORE(q, 0); if (kt + 4 < nk) SW_LOAD(q, kt + 4);
            __syncthreads();
        }
#undef SW_LOAD
#undef SW_STORE
#undef SW_COMPUTE
        const int row = row0 + wm * 32 + l32, cb = c0 + wn * 32 + 4 * half;
        const float sc = rsqrtf(ssq[row] * (1.0f / D) + NEPS);
#pragma unroll
        for (int g = 0; g < 4; ++g) {
            float o[4];
#pragma unroll
            for (int i = 0; i < 4; ++i) { const float gg = ag[4 * g + i] * sc, uu = au[4 * g + i] * sc; o[i] = gg * sigm(gg) * uu; }
            u32x2 w; w.x = pk2(o[0], o[1]); w.y = pk2(o[2], o[3]);
            *(u32x2*)(act + (size_t)row * DFF + cb + 8 * g) = w;
        }
    }
}

DI void cvt_weight(const float* __restrict__ src, int K, int N, u16* __restrict__ dst, int Kpad, int Nw, int row_off, int il, int& tbase, LAS u16* T, const int wv, const int rank, const int G) {
    const int tid = opaque_tid(wv);
    const int nkt = Kpad / 64, nnt = (Nw + 63) / 64, ntile = nkt * nnt;
    int first = rank - (tbase % G); if (first < 0) first += G;
    for (int tile = first; tile < ntile; tile += G) {
        const int n0 = (tile % nnt) * 64, k0 = (tile / nnt) * 64;
#pragma unroll
        for (int i = 0; i < 2; ++i) {
            const int kl = (tid >> 4) + 32 * i, nl = (tid & 15) * 4, k = k0 + kl, n = n0 + nl;
            f32x4 v = (f32x4){0.f, 0.f, 0.f, 0.f};
            if (k < K && n < N) v = __builtin_nontemporal_load((const f32x4*)(src + (size_t)k * N + n));
#pragma unroll
            for (int j = 0; j < 4; ++j) T[(nl + j) * 72 + kl] = (u16)f2bf(v[j]);
        }
        __syncthreads();
        {
            const int nl = tid >> 3, kk = (tid & 7) * 8, n = n0 + nl;
            if (n < Nw) {
                const int drow = il ? (((n >> 7) << 8) + row_off + (n & 127)) : (row_off + n);
                *(u32x4*)(dst + (size_t)drow * Kpad + k0 + kk) = *(const LAS u32x4*)(T + nl * 72 + kk);
            }
        }
        __syncthreads();
    }
    tbase += ntile;
}

__device__ __forceinline__ void convert_group(PP p, LAS unsigned char* lds, const int wv, const int grp, const int rank, const int nblk) {
    unsigned char* ws = p->ws; LAS u16* T = (LAS u16*)lds; int tb = 0;
    const size_t DD = (size_t)D * D;
    if (grp == 0) {
        u16* win0 = (u16*)(ws + OFF_W_IN0);
        cvt_weight(p->in[I_MQ], D, 1024, win0, D, 1024, 0, 0, tb, T, wv, rank, nblk);
        cvt_weight(p->in[I_MK], D, 1024, win0, D, 1024, 1024, 0, tb, T, wv, rank, nblk);
        cvt_weight(p->in[I_MV], D, 2048, win0, D, 2048, 2048, 0, tb, T, wv, rank, nblk);
        cvt_weight(p->in[I_MOG], D, 2048, win0, D, 2048, 4096, 0, tb, T, wv, rank, nblk);
        cvt_weight(p->in[I_MIG], D, 8, win0, D, 8, 6144, 0, tb, T, wv, rank, nblk);
        cvt_weight(p->in[I_MFG], D, 8, win0, D, 248, 6152, 0, tb, T, wv, rank, nblk);
        cvt_weight(p->in[I_PWP], 256, D, (u16*)(ws + OFF_W_PP), 256, D, 0, 0, tb, T, wv, rank, nblk);
    } else {
        const int l = grp - 1;
        if (l == 0) cvt_weight(p->in[I_MOUT], D, 2048, (u16*)(ws + OFF_W_OUT0), D, 2048, 0, 0, tb, T, wv, rank, nblk);
        else cvt_weight(p->in[I_RWO], D, D, (u16*)(ws + OFF_W_OUT1), D, D, 0, 0, tb, T, wv, rank, nblk);
        cvt_weight(p->in[I_FG] + (size_t)l * D * DFF, D, DFF, (u16*)(ws + OFF_W_GU + l * SZ_W_GU), D, DFF, 0, 1, tb, T, wv, rank, nblk);
        cvt_weight(p->in[I_FU] + (size_t)l * D * DFF, D, DFF, (u16*)(ws + OFF_W_GU + l * SZ_W_GU), D, DFF, 128, 1, tb, T, wv, rank, nblk);
        cvt_weight(p->in[I_FD] + (size_t)l * D * DFF, DFF, D, (u16*)(ws + OFF_W_DN + l * SZ_W_DN), DFF, D, 0, 0, tb, T, wv, rank, nblk);
        cvt_weight(p->in[I_PWG] + l * DD, D, D, (u16*)(ws + OFF_W_PG + l * SZ_SQ), D, D, 0, 0, tb, T, wv, rank, nblk);
        if (l == 0) {
            cvt_weight(p->in[I_PWP] + (size_t)256 * D, 256, D, (u16*)(ws + OFF_W_PP + SZ_W_PP), 256, D, 0, 0, tb, T, wv, rank, nblk);
            u16* win1 = (u16*)(ws + OFF_W_IN1);
            cvt_weight(p->in[I_RWR], D, D, win1, D, D, 0, 0, tb, T, wv, rank, nblk);
            cvt_weight(p->in[I_RWK], D, D, win1, D, D, 2048, 0, tb, T, wv, rank, nblk);
            cvt_weight(p->in[I_RWV], D, D, win1, D, D, 4096, 0, tb, T, wv, rank, nblk);
            cvt_weight(p->in[I_RW1], D, 96, win1, D, 256, 6144, 0, tb, T, wv, rank, nblk);
            cvt_weight(p->in[I_RA1], D, 96, win1, D, 256, 6400, 0, tb, T, wv, rank, nblk);
            cvt_weight(p->in[I_RG1], D, 256, win1, D, 256, 6656, 0, tb, T, wv, rank, nblk);
            cvt_weight(p->in[I_RW2], 96, D, (u16*)(ws + OFF_W_L2), 256, D, 0, 0, tb, T, wv, rank, nblk);
            cvt_weight(p->in[I_RA2], 96, D, (u16*)(ws + OFF_W_L2 + SZ_W_PP), 256, D, 0, 0, tb, T, wv, rank, nblk);
            cvt_weight(p->in[I_RG2], 256, D, (u16*)(ws + OFF_W_L2 + 2 * SZ_W_PP), 256, D, 0, 0, tb, T, wv, rank, nblk);
        }
    }
}
__device__ __forceinline__ void phase0(PP p, LAS unsigned char* lds, const int wv) {
    unsigned char* ws = p->ws;
    convert_group(p, lds, wv, 0, (int)blockIdx.x, (int)gridDim.x);
    const int tid = opaque_tid(wv), wid = tid >> 6, lane = tid & 63;
    {
        u16* h = (u16*)(ws + OFF_H); u16* an = (u16*)(ws + OFF_BIG);
        const float* gam = p->in[I_NMIX];
        for (int row = blockIdx.x * 8 + wid; row < MT; row += gridDim.x * 8) {
            const float* xr = row < MPR ? p->in[I_XP] + (size_t)row * D : p->in[I_XS] + (size_t)(row - MPR) * D;
            f32x4 v[8]; float ss = 0.f;
#pragma unroll
            for (int i = 0; i < 8; ++i) { v[i] = __builtin_nontemporal_load((const f32x4*)(xr + 4 * (lane + 64 * i))); ss += v[i][0] * v[i][0] + v[i][1] * v[i][1] + v[i][2] * v[i][2] + v[i][3] * v[i][3]; }
            ss = wave_sum(ss);
            const float rs = rsqrtf(ss * (1.0f / D) + NEPS);
#pragma unroll
            for (int i = 0; i < 8; ++i) {
                const int c = 4 * (lane + 64 * i);
                { u32x2 hw; hw.x = pk2(v[i][0], v[i][1]); hw.y = pk2(v[i][2], v[i][3]); *(u32x2*)(h + (size_t)row * D + c) = hw; }
                const f32x4 g = *(const f32x4*)(gam + c);
                u32x2 w; w.x = pk2(v[i][0] * rs * g[0], v[i][1] * rs * g[1]); w.y = pk2(v[i][2] * rs * g[2], v[i][3] * rs * g[3]);
                *(u32x2*)(an + (size_t)row * D + c) = w;
            }
        }
    }
    {
        u16* ap = (u16*)(ws + OFF_AP);
        const int nitem = 2 * MT * 64;
        for (int it = blockIdx.x * 512 + tid; it < nitem; it += gridDim.x * 512) {
            const int c = (it & 63) * 4, rl = it >> 6, l = rl / MT, row = rl - l * MT;
            const float* src = row < MPR ? p->in[I_PP] + ((size_t)l * MPR + row) * 256 + c : p->in[I_PS] + ((size_t)l * 1024 + (row - MPR)) * 256 + c;
            const f32x4 v = __builtin_nontemporal_load((const f32x4*)src);
            u32x2 w; w.x = pk2(v[0], v[1]); w.y = pk2(v[2], v[3]);
            *(u32x2*)(ap + (size_t)rl * 256 + c) = w;
        }
    }
    { float* ssq = (float*)(ws + OFF_SSQ); for (int i = blockIdx.x * 512 + tid; i < 5 * MT; i += gridDim.x * 512) ssq[i] = 0.f; }
}

#define MLSTM_LOADS(ROW0) do { const int row0_ = (ROW0); int tid_ = tid; asm volatile("" : "+v"(tid_)); \
    _Pragma("unroll") for (int i = 0; i < 2; ++i) { const int idx = tid_ + 512 * i, t = idx >> 4, d8 = (idx & 15) * 8; \
        pq[i] = (u32x4){0u, 0u, 0u, 0u}; pk[i] = pq[i]; \
        if (t < valid) { pq[i] = *(const u32x4*)(qb + (size_t)(row0_ + t) * 1024 + hd * 128 + d8); pk[i] = *(const u32x4*)(kb + (size_t)(row0_ + t) * 1024 + hd * 128 + d8); } } \
    _Pragma("unroll") for (int i = 0; i < 2; ++i) { const int it = tid_ + 512 * i, tp = it & 31, e8 = (it >> 5) * 8, t0 = 2 * tp; \
        pv0[i] = (u32x4){0u, 0u, 0u, 0u}; pv1[i] = pv0[i]; \
        if (t0 < valid) pv0[i] = *(const u32x4*)(vb + (size_t)(row0_ + t0) * 2048 + hd * 256 + e8); \
        if (t0 + 1 < valid) pv1[i] = *(const u32x4*)(vb + (size_t)(row0_ + t0 + 1) * 2048 + hd * 256 + e8); } } while (0)
__device__ __forceinline__ void mlstm_scan(PP p, LAS unsigned char* lds, const int wv) {
    const int tid = opaque_tid(wv), wid = tid >> 6, lane = tid & 63, l32 = lane & 31, half = lane >> 5;
    LAS u16* Qs = (LAS u16*)(lds + 0);
    LAS u16* Ks = (LAS u16*)(lds + 17408);
    LAS u16* KwT = (LAS u16*)(lds + 34816);
    LAS u16* VT = (LAS u16*)(lds + 53248);
    LAS u16* Sp = (LAS u16*)(lds + 90112);
    LAS u16* Hs = (LAS u16*)(lds + 99328);
    LAS float* sg = (LAS float*)(lds + 133120);
    LAS float* sM = sg + 64; LAS float* swk = sg + 128; LAS float* swi = sg + 192; LAS float* sen = sg + 256; LAS float* sinv = sg + 320;
    LAS float* n_s = sg + 384; LAS float* sc = sg + 512; LAS float* nw_s = sg + 576;
    unsigned char* ws = p->ws;
    const u16* qb = (const u16*)(ws + OFF_BIG + SZ_ACT); const u16* kb = (const u16*)(ws + OFF_BIG + SZ_ACT + SZ_ACT / 2);
    const u16* vb = (const u16*)(ws + OFF_BIG + 2 * SZ_ACT); const u16* ob = (const u16*)(ws + OFF_BIG + 3 * SZ_ACT);
    u16* aout = (u16*)(ws + OFF_BIG + 5 * SZ_ACT);
    const float* lig = (const float*)(ws + OFF_LG); const float* lfg = lig + (size_t)MT * 8;
    const float* normw = p->in[I_MNW];

    const int G = gridDim.x, bid = blockIdx.x;
    int u0, ust;
    if (G > 64) { if (bid < 32) { u0 = bid; ust = 1 << 20; } else { u0 = 32 + (bid - 32); ust = G - 32; } } else { u0 = bid; ust = G; }
    for (int u = u0; u < 1056; u += ust) {
        const bool pr = u < 32; int b, hd, row_base, nchunk, valid;
        if (pr) { b = u >> 3; hd = u & 7; row_base = b * 2048; nchunk = 32; valid = 64; }
        else { const int s = u - 32; b = s >> 3; hd = s & 7; row_base = MPR + b * 8; nchunk = 1; valid = 8; }
        const int bh = b * 8 + hd;
        f32x16 Cacc[4];
        if (pr) {
#pragma unroll
            for (int dt = 0; dt < 4; ++dt)
#pragma unroll
                for (int j = 0; j < 16; ++j) Cacc[dt][j] = 0.f;
        } else {
            int lq = lane; asm volatile("" : "+v"(lq));
            const float* C0 = p->in[I_MC] + (size_t)bh * 32768 + ((lq >> 5) * 4) * 256 + 32 * wid + (lq & 31);
#pragma unroll
            for (int dt = 0; dt < 4; ++dt)
#pragma unroll
                for (int j = 0; j < 16; ++j) Cacc[dt][j] = __builtin_nontemporal_load(C0 + (32 * dt + crow(j, 0)) * 256);
        }
        if (tid < 128) n_s[tid] = pr ? 0.f : p->in[I_MN][bh * 128 + tid];
        if (tid == 0) sc[0] = pr ? 0.f : p->in[I_MM][bh];
        if (tid < 256) nw_s[tid] = normw[hd * 256 + tid];
        u32x4 pq[2], pk[2], pv0[2], pv1[2];
        MLSTM_LOADS(row_base);
        float nli = -1e30f, nlf = 0.f;
        if (wid == 0 && lane < valid) { nli = lig[(size_t)(row_base + lane) * 8 + hd]; nlf = lfg[(size_t)(row_base + lane) * 8 + hd]; }
        __syncthreads();
        for (int c = 0; c < nchunk; ++c) {
            const int row0 = row_base + 64 * c;
            int tidc = tid; asm volatile("" : "+v"(tidc));
            const int lanec = tidc & 63, l32c = lanec & 31, halfc = lanec >> 5;
            if (wid == 0) {
                const int t = lanec; const float m = sc[0];
                const float li_t = nli, lf_t = nlf;
                if (c + 1 < nchunk) { nli = lig[(size_t)(row0 + 64 + t) * 8 + hd]; nlf = lfg[(size_t)(row0 + 64 + t) * 8 + hd]; }
                float bsum = lf_t;
#pragma unroll
                for (int o = 1; o < 64; o <<= 1) { const float x = __shfl_up(bsum, o); if (lanec >= o) bsum += x; }
                const float gs = li_t - bsum;
                float pm = gs;
#pragma unroll
                for (int o = 1; o < 64; o <<= 1) { const float x = __shfl_up(pm, o); if (lanec >= o) pm = fmaxf(pm, x); }
                const float M = fmaxf(m, pm);
                const float M63 = __shfl(M, 63), b63 = __shfl(bsum, 63);
                sg[t] = gs; sM[t] = M; swk[t] = __expf(gs - M63); swi[t] = __expf(m - M); sen[t] = __expf(-(bsum + M));
                if (lanec == 0) { sc[1] = __expf(m - M63); sc[2] = b63 + M63; }
            }
            __syncthreads();
#pragma unroll
            for (int i = 0; i < 2; ++i) {
                const int idx = tidc + 512 * i, t = idx >> 4, d8 = (idx & 15) * 8;
                *(LAS u32x4*)(Qs + t * 136 + d8) = pq[i]; *(LAS u32x4*)(Ks + t * 136 + d8) = pk[i];
            }
#pragma unroll
            for (int i = 0; i < 2; ++i) {
                const int it = tidc + 512 * i, tp = it & 31, e8 = (it >> 5) * 8, t0 = 2 * tp;
#pragma unroll
                for (int j = 0; j < 4; ++j) {
                    *(LAS unsigned*)(VT + (e8 + 2 * j) * 72 + t0) = (pv0[i][j] & 0xFFFFu) | (pv1[i][j] << 16);
                    *(LAS unsigned*)(VT + (e8 + 2 * j + 1) * 72 + t0) = (pv0[i][j] >> 16) | (pv1[i][j] & 0xFFFF0000u);
                }
            }
            __syncthreads();
            {
                const int tp = tidc & 31, d8 = (tidc >> 5) * 8, t0 = 2 * tp;
                const u32x4 k0 = *(const LAS u32x4*)(Ks + t0 * 136 + d8), k1 = *(const LAS u32x4*)(Ks + (t0 + 1) * 136 + d8);
                const float w0 = swk[t0], w1 = swk[t0 + 1];
#pragma unroll
                for (int j = 0; j < 4; ++j) {
                    *(LAS unsigned*)(KwT + (d8 + 2 * j) * 72 + t0) = pk2(bflo(k0[j]) * w0, bflo(k1[j]) * w1);
                    *(LAS unsigned*)(KwT + (d8 + 2 * j + 1) * 72 + t0) = pk2(bfhi(k0[j]) * w0, bfhi(k1[j]) * w1);
                }
            }
            if (wid < 4) {
                const int ti = wid >> 1, si = wid & 1;
                if (si <= ti) {
                    f32x16 a;
#pragma unroll
                    for (int j = 0; j < 16; ++j) a[j] = 0.f;
#pragma unroll
                    for (int kk = 0; kk < 8; ++kk) {
                        const bf16x8 af = *(const LAS bf16x8*)(Qs + (32 * ti + l32c) * 136 + 16 * kk + 8 * halfc);
                        const bf16x8 bf = *(const LAS bf16x8*)(Ks + (32 * si + l32c) * 136 + 16 * kk + 8 * halfc);
                        a = __builtin_amdgcn_mfma_f32_32x32x16_bf16(af, bf, a, 0, 0, 0);
                    }
                    const int s = 32 * si + l32c; const float gss = sg[s];
#pragma unroll
                    for (int j = 0; j < 16; ++j) {
                        const int t = 32 * ti + crow(j, halfc);
                        const float val = (s <= t) ? a[j] * __expf(gss - sM[t]) : 0.f;
                        Sp[t * 72 + s] = (u16)f2bf(val);
                    }
                } else {
#pragma unroll
                    for (int j = 0; j < 16; ++j) Sp[crow(j, halfc) * 72 + 32 + l32c] = 0;
                }
            }
            __syncthreads();
            {
                const int t = tidc >> 3, part = tidc & 7;
                const u32x4 sv = *(const LAS u32x4*)(Sp + t * 72 + 8 * part);
                float a = bflo(sv.x) + bfhi(sv.x) + bflo(sv.y) + bfhi(sv.y) + bflo(sv.z) + bfhi(sv.z) + bflo(sv.w) + bfhi(sv.w);
                const u32x4 q0 = *(const LAS u32x4*)(Qs + t * 136 + 16 * part), q1 = *(const LAS u32x4*)(Qs + t * 136 + 16 * part + 8);
                float qn = 0.f;
#pragma unroll
                for (int j = 0; j < 4; ++j) {
                    qn += bflo(q0[j]) * n_s[16 * part + 2 * j] + bfhi(q0[j]) * n_s[16 * part + 2 * j + 1];
                    qn += bflo(q1[j]) * n_s[16 * part + 8 + 2 * j] + bfhi(q1[j]) * n_s[16 * part + 8 + 2 * j + 1];
                }
                float tot = a + swi[t] * qn;
                tot = grp8_sum(tot);
                if (part == 0) sinv[t] = 1.0f / fmaxf(fabsf(tot), sen[t]);
            }
            f32x16 N0, N1;
#pragma unroll
            for (int j = 0; j < 16; ++j) { N0[j] = 0.f; N1[j] = 0.f; }
#pragma unroll
            for (int dt = 0; dt < 4; ++dt)
#pragma unroll
                for (int kb2 = 0; kb2 < 2; ++kb2) {
                    u32x4 bw;
                    bw.x = pk2(Cacc[dt][8 * kb2 + 0], Cacc[dt][8 * kb2 + 1]); bw.y = pk2(Cacc[dt][8 * kb2 + 2], Cacc[dt][8 * kb2 + 3]);
                    bw.z = pk2(Cacc[dt][8 * kb2 + 4], Cacc[dt][8 * kb2 + 5]); bw.w = pk2(Cacc[dt][8 * kb2 + 6], Cacc[dt][8 * kb2 + 7]);
                    const bf16x8 bfr = __builtin_bit_cast(bf16x8, bw);
#pragma unroll
                    for (int tt = 0; tt < 2; ++tt) {
                        const LAS u16* qp = Qs + (32 * tt + l32c) * 136 + 32 * dt + 16 * kb2 + 4 * halfc;
                        const u32x2 lo = *(const LAS u32x2*)qp, hi = *(const LAS u32x2*)(qp + 8);
                        u32x4 aw; aw.x = lo.x; aw.y = lo.y; aw.z = hi.x; aw.w = hi.y;
                        const bf16x8 afr = __builtin_bit_cast(bf16x8, aw);
                        if (tt == 0) N0 = __builtin_amdgcn_mfma_f32_32x32x16_bf16(afr, bfr, N0, 0, 0, 0);
                        else N1 = __builtin_amdgcn_mfma_f32_32x32x16_bf16(afr, bfr, N1, 0, 0, 0);
                    }
                    __builtin_amdgcn_sched_barrier(0);
                }
#pragma unroll
            for (int j = 0; j < 16; ++j) { N0[j] *= swi[crow(j, halfc)]; N1[j] *= swi[32 + crow(j, halfc)]; }
            bf16x8 vf[4];
#pragma unroll
            for (int k4 = 0; k4 < 4; ++k4) vf[k4] = *(const LAS bf16x8*)(VT + (32 * wid + l32c) * 72 + 16 * k4 + 8 * halfc);
#pragma unroll
            for (int k4 = 0; k4 < 4; ++k4) {
                if (k4 < 2) { const bf16x8 af = *(const LAS bf16x8*)(Sp + l32c * 72 + 16 * k4 + 8 * halfc); N0 = __builtin_amdgcn_mfma_f32_32x32x16_bf16(af, vf[k4], N0, 0, 0, 0); }
                const bf16x8 af1 = *(const LAS bf16x8*)(Sp + (32 + l32c) * 72 + 16 * k4 + 8 * halfc); N1 = __builtin_amdgcn_mfma_f32_32x32x16_bf16(af1, vf[k4], N1, 0, 0, 0);
            }
            const float decay = sc[1];
#pragma unroll
            for (int dt = 0; dt < 4; ++dt) {
#pragma unroll
                for (int j = 0; j < 16; ++j) Cacc[dt][j] *= decay;
#pragma unroll
                for (int k4 = 0; k4 < 4; ++k4) {
                    const bf16x8 af = *(const LAS bf16x8*)(KwT + (32 * dt + l32c) * 72 + 16 * k4 + 8 * halfc);
                    Cacc[dt] = __builtin_amdgcn_mfma_f32_32x32x16_bf16(af, vf[k4], Cacc[dt], 0, 0, 0);
                }
                __builtin_amdgcn_sched_barrier(0);
            }
            __builtin_amdgcn_sched_barrier(0);
            if (c + 1 < nchunk) MLSTM_LOADS(row0 + 64);
            __syncthreads();
#pragma unroll
            for (int j = 0; j < 16; ++j) {
                const int t0 = crow(j, halfc), t1 = 32 + t0;
                Hs[t0 * 264 + 32 * wid + l32c] = (u16)f2bf(N0[j] * sinv[t0]);
                Hs[t1 * 264 + 32 * wid + l32c] = (u16)f2bf(N1[j] * sinv[t1]);
            }
            __syncthreads();
            {
                const int t = tidc >> 3, part = tidc & 7;
                u32x4 hv[4]; float ss = 0.f;
#pragma unroll
                for (int c4 = 0; c4 < 4; ++c4) {
                    hv[c4] = *(const LAS u32x4*)(Hs + t * 264 + 32 * part + 8 * c4);
#pragma unroll
                    for (int j = 0; j < 4; ++j) { const float a = bflo(hv[c4][j]), bq = bfhi(hv[c4][j]); ss += a * a + bq * bq; }
                }
                ss = grp8_sum(ss);
                const float rs = rsqrtf(ss * (1.0f / 256.0f) + NEPS);
                if (t < valid) {
                    const size_t gofs = (size_t)(row0 + t) * 2048 + hd * 256 + 32 * part;
#pragma unroll
                    for (int c4 = 0; c4 < 4; ++c4) {
                        const u32x4 o8 = *(const u32x4*)(ob + gofs + 8 * c4);
                        const f32x4 w0 = *(const LAS f32x4*)(nw_s + 32 * part + 8 * c4), w1 = *(const LAS f32x4*)(nw_s + 32 * part + 8 * c4 + 4);
                        u32x4 r;
                        r.x = pk2(bflo(hv[c4].x) * rs * w0[0] * bflo(o8.x), bfhi(hv[c4].x) * rs * w0[1] * bfhi(o8.x));
                        r.y = pk2(bflo(hv[c4].y) * rs * w0[2] * bflo(o8.y), bfhi(hv[c4].y) * rs * w0[3] * bfhi(o8.y));
                        r.z = pk2(bflo(hv[c4].z) * rs * w1[0] * bflo(o8.z), bfhi(hv[c4].z) * rs * w1[1] * bfhi(o8.z));
                        r.w = pk2(bflo(hv[c4].w) * rs * w1[2] * bflo(o8.w), bfhi(hv[c4].w) * rs * w1[3] * bfhi(o8.w));
                        *(u32x4*)(aout + gofs + 8 * c4) = r;
                    }
                }
            }
            if (tidc < 128) {
                float s = 0.f;
#pragma unroll
                for (int i = 0; i < 8; ++i) {
                    const u32x4 kv = *(const LAS u32x4*)(KwT + tidc * 72 + 8 * i);
                    s += bflo(kv.x) + bfhi(kv.x) + bflo(kv.y) + bfhi(kv.y) + bflo(kv.z) + bfhi(kv.z) + bflo(kv.w) + bfhi(kv.w);
                }
                n_s[tidc] = decay * n_s[tidc] + s;
            }
            if (tidc == 0) sc[0] = sc[2];
            __syncthreads();
        }
        int lq2 = lane; asm volatile("" : "+v"(lq2));
        float* Co = p->out + (pr ? O_CP : O_CS) + (size_t)bh * 32768 + ((lq2 >> 5) * 4) * 256 + 32 * wid + (lq2 & 31);
#pragma unroll
        for (int dt = 0; dt < 4; ++dt)
#pragma unroll
            for (int j = 0; j < 16; ++j) __builtin_nontemporal_store(Cacc[dt][j], Co + (32 * dt + crow(j, 0)) * 256);
        if (tid < 128) p->out[(pr ? O_NP : O_NS) + (size_t)bh * 128 + tid] = n_s[tid];
        if (tid == 0) p->out[(pr ? O_MP : O_MS) + bh] = sc[0];
        __syncthreads();
    }
}

__device__ __forceinline__ void rwkv_norm_mix(PP p, const int wv) {
    const int tid = opaque_tid(wv), wid = tid >> 6, lane = tid & 63;
    unsigned char* ws = p->ws;
    const u16* h = (const u16*)(ws + OFF_H); u16* a6 = (u16*)(ws + OFF_BIG);
    const float* gam = p->in[I_NMIX] + D; const float* mu = p->in[I_RMU];
    for (int row = blockIdx.x * 8 + wid; row < MT; row += gridDim.x * 8) {
        int b, t, T;
        if (row < MPR) { b = row >> 11; t = row & 2047; T = 2048; } else { b = (row - MPR) >> 3; t = (row - MPR) & 7; T = 8; }
        const u16* hr = h + (size_t)row * D;
        f32x4 v[8], pv[8]; float ss = 0.f, ps = 0.f;
#pragma unroll
        for (int i = 0; i < 8; ++i) { v[i] = ld_bf16x4(hr + 4 * (lane + 64 * i)); ss += v[i][0] * v[i][0] + v[i][1] * v[i][1] + v[i][2] * v[i][2] + v[i][3] * v[i][3]; }
        if (t > 0) {
#pragma unroll
            for (int i = 0; i < 8; ++i) { pv[i] = ld_bf16x4(hr - D + 4 * (lane + 64 * i)); ps += pv[i][0] * pv[i][0] + pv[i][1] * pv[i][1] + pv[i][2] * pv[i][2] + pv[i][3] * pv[i][3]; }
        } else {
#pragma unroll
            for (int i = 0; i < 8; ++i) pv[i] = (row < MPR) ? (f32x4){0.f, 0.f, 0.f, 0.f} : *(const f32x4*)(p->in[I_RSH] + (size_t)b * D + 4 * (lane + 64 * i));
        }
        ss = wave_sum(ss); ps = wave_sum(ps);
        const float rs = rsqrtf(ss * (1.0f / D) + NEPS), prs = rsqrtf(ps * (1.0f / D) + NEPS);
        float* sh = (t == T - 1) ? p->out + (row < MPR ? O_SHP : O_SHS) + (size_t)b * D : nullptr;
#pragma unroll
        for (int i = 0; i < 8; ++i) {
            const int c = 4 * (lane + 64 * i);
            const f32x4 g = *(const f32x4*)(gam + c);
            f32x4 xn, xp;
#pragma unroll
            for (int j = 0; j < 4; ++j) { xn[j] = v[i][j] * rs * g[j]; xp[j] = (t > 0) ? pv[i][j] * prs * g[j] : pv[i][j]; }
            if (sh) *(f32x4*)(sh + c) = xn;
            const f32x4 xx = xp - xn;
#pragma unroll
            for (int mi = 0; mi < 6; ++mi) {
                const int msrc = (mi == 0) ? 0 : (mi == 1) ? 2 : (mi == 2) ? 3 : (mi == 3) ? 1 : mi;
                const f32x4 m4 = *(const f32x4*)(mu + (size_t)msrc * D + c);
                const f32x4 o = xn + xx * m4;
                u32x2 w; w.x = pk2(o[0], o[1]); w.y = pk2(o[2], o[3]);
                __builtin_nontemporal_store(w, (u32x2*)(a6 + (size_t)mi * MT * D + (size_t)row * D + c));
            }
        }
    }
}

struct RwkvJob { int row_base, t0, nt, hd, buf; };
DI void rwkv_prep(PP p, LAS float* vec, LAS float* bon, const RwkvJob& jb, int pt, int c8, unsigned char* ws) {
    const u16* rb = (const u16*)(ws + OFF_BIG + 6 * SZ_ACT); const u16* kbuf = rb + (size_t)MT * D; const u16* vbuf = kbuf + (size_t)MT * D;
    const float* wbuf = (const float*)(ws + OFF_BIG); const float* abuf = (const float*)(ws + OFF_BIG + 2 * SZ_ACT);
    const int hc = jb.hd * 64 + c8;
    const size_t go = (size_t)(jb.row_base + jb.t0 + (pt < jb.nt ? pt : 0)) * D + hc;
    const u32x4 r8 = __builtin_nontemporal_load((const u32x4*)(rb + go)), k8 = __builtin_nontemporal_load((const u32x4*)(kbuf + go)), v8 = __builtin_nontemporal_load((const u32x4*)(vbuf + go));
    f32x4 wA = __builtin_nontemporal_load((const f32x4*)(wbuf + go)), wB = __builtin_nontemporal_load((const f32x4*)(wbuf + go + 4)), aA, aB; { const u32x4 a8 = __builtin_nontemporal_load((const u32x4*)((const u16*)abuf + go)); aA = (f32x4){bflo(a8.x), bfhi(a8.x), bflo(a8.y), bfhi(a8.y)}; aB = (f32x4){bflo(a8.z), bfhi(a8.z), bflo(a8.w), bfhi(a8.w)}; }
    const f32x4 kk0 = *(const f32x4*)(p->in[I_RKK] + hc), kk1 = *(const f32x4*)(p->in[I_RKK] + hc + 4);
    const f32x4 ka0 = *(const f32x4*)(p->in[I_RKA] + hc), ka1 = *(const f32x4*)(p->in[I_RKA] + hc + 4);
    const f32x4 rk0 = *(const f32x4*)(p->in[I_RRK] + hc), rk1 = *(const f32x4*)(p->in[I_RRK] + hc + 4);
    float r[8], k[8], v[8], w[8], a[8];
#pragma unroll
    for (int j = 0; j < 4; ++j) {
        r[2 * j] = bflo(r8[j]); r[2 * j + 1] = bfhi(r8[j]); k[2 * j] = bflo(k8[j]); k[2 * j + 1] = bfhi(k8[j]); v[2 * j] = bflo(v8[j]); v[2 * j + 1] = bfhi(v8[j]);
        w[j] = __expf(-__expf(-softplus(-wA[j]) - 0.5f)); w[4 + j] = __expf(-__expf(-softplus(-wB[j]) - 0.5f)); a[j] = sigm(aA[j]); a[4 + j] = sigm(aB[j]);
    }
    float kkv[8], kp[8]; float ss = 0.f, bs = 0.f, c2 = 0.f;
#pragma unroll
    for (int j = 0; j < 8; ++j) {
        const float kkw = j < 4 ? kk0[j] : kk1[j - 4], kaw = j < 4 ? ka0[j] : ka1[j - 4], rkw = j < 4 ? rk0[j] : rk1[j - 4];
        kkv[j] = k[j] * kkw; ss += kkv[j] * kkv[j];
        kp[j] = k[j] * (1.0f + (a[j] - 1.0f) * kaw);
        bs += r[j] * kp[j] * rkw; c2 += r[j] * kp[j];
    }
    ss = dpp_sum8(ss); bs = dpp_sum8(bs); c2 = dpp_sum8(c2);
    const float inv = 1.0f / fmaxf(sqrtf(ss), 1e-12f);
    LAS float* vp = vec + jb.buf * (32 * 448) + pt * 448 + c8;
    f32x4 o0, o1, b0, b1, q0, q1;
    float c1 = 0.f;
#pragma unroll
    for (int j = 0; j < 4; ++j) {
        o0[j] = kkv[j] * inv; o1[j] = kkv[4 + j] * inv; b0[j] = o0[j] * a[j]; b1[j] = o1[j] * a[4 + j];
        q0[j] = w[j] * r[j]; q1[j] = w[4 + j] * r[4 + j]; c1 += b0[j] * r[j] + b1[j] * r[4 + j];
    }
    c1 = dpp_sum8(c1);
    *(LAS f32x4*)(vp) = o0; *(LAS f32x4*)(vp + 4) = o1;
    *(LAS f32x4*)(vp + 64) = (f32x4){w[0], w[1], w[2], w[3]}; *(LAS f32x4*)(vp + 68) = (f32x4){w[4], w[5], w[6], w[7]};
    *(LAS f32x4*)(vp + 128) = b0; *(LAS f32x4*)(vp + 132) = b1;
    *(LAS f32x4*)(vp + 192) = (f32x4){kp[0], kp[1], kp[2], kp[3]}; *(LAS f32x4*)(vp + 196) = (f32x4){kp[4], kp[5], kp[6], kp[7]};
    *(LAS f32x4*)(vp + 256) = q0; *(LAS f32x4*)(vp + 260) = q1;
    *(LAS f32x4*)(vp + 320) = (f32x4){v[0], v[1], v[2], v[3]}; *(LAS f32x4*)(vp + 324) = (f32x4){v[4], v[5], v[6], v[7]};
    if (c8 == 0) { vec[jb.buf * (32 * 448) + pt * 448 + 384] = c1; vec[jb.buf * (32 * 448) + pt * 448 + 385] = c2; bon[jb.buf * 32 + pt] = bs; }
}
DI void rwkv_post(PP p, const LAS float* vec, const LAS float* ybuf, const LAS float* bon, const RwkvJob& jb, int pt, int c8, unsigned char* ws) {
    const u16* gbuf = (const u16*)(ws + OFF_BIG + 4 * SZ_ACT); u16* aout = (u16*)(ws + OFF_BIG + 5 * SZ_ACT);
    const int hc = jb.hd * 64 + c8;
    const LAS float* yp = ybuf + jb.buf * (32 * 64) + pt * 64 + c8;
    const f32x4 y0 = *(const LAS f32x4*)yp, y1 = *(const LAS f32x4*)(yp + 4);
    float sm = y0[0] + y0[1] + y0[2] + y0[3] + y1[0] + y1[1] + y1[2] + y1[3];
    sm = dpp_sum8(sm);
    const float mean = sm * (1.0f / 64.0f);
    const f32x4 d0 = y0 - mean, d1 = y1 - mean;
    float vs = d0[0] * d0[0] + d0[1] * d0[1] + d0[2] * d0[2] + d0[3] * d0[3] + d1[0] * d1[0] + d1[1] * d1[1] + d1[2] * d1[2] + d1[3] * d1[3];
    vs = dpp_sum8(vs);
    const float rstd = rsqrtf(vs * (1.0f / 64.0f) + 64e-5f);
    if (pt < jb.nt) {
        const size_t go = (size_t)(jb.row_base + jb.t0 + pt) * D + hc;
        const u32x4 g8 = __builtin_nontemporal_load((const u32x4*)(gbuf + go));
        const f32x4 lw0 = *(const f32x4*)(p->in[I_RLNW] + hc), lw1 = *(const f32x4*)(p->in[I_RLNW] + hc + 4);
        const f32x4 lb0 = *(const f32x4*)(p->in[I_RLNB] + hc), lb1 = *(const f32x4*)(p->in[I_RLNB] + hc + 4);
        const LAS float* vp = vec + jb.buf * (32 * 448) + pt * 448 + 320 + c8;
        const f32x4 vv0 = *(const LAS f32x4*)vp, vv1 = *(const LAS f32x4*)(vp + 4);
        const float bo = bon[jb.buf * 32 + pt];
        f32x4 o0, o1;
#pragma unroll
        for (int j = 0; j < 4; ++j) { o0[j] = d0[j] * rstd * lw0[j] + lb0[j] + bo * vv0[j]; o1[j] = d1[j] * rstd * lw1[j] + lb1[j] + bo * vv1[j]; }
        u32x4 r;
        r.x = pk2(o0[0] * bflo(g8.x), o0[1] * bfhi(g8.x)); r.y = pk2(o0[2] * bflo(g8.y), o0[3] * bfhi(g8.y));
        r.z = pk2(o1[0] * bflo(g8.z), o1[1] * bfhi(g8.z)); r.w = pk2(o1[2] * bflo(g8.w), o1[3] * bfhi(g8.w));
        *(u32x4*)(aout + go) = r;
    }
}
typedef float f32x2 __attribute__((ext_vector_type(2)));
#define RSTEP_DECL(n) f32x4 n##k0, n##k1, n##w0, n##w1, n##b0, n##b1, n##p0, n##p1, n##r0, n##r1; float n##vA, n##vB; f32x2 n##cc
#define RSTEP_LOAD(n, q, qs) do { const LAS float* q_ = (q); const LAS float* qs_ = (qs); \
    n##k0 = *(const LAS f32x4*)(q_); n##k1 = *(const LAS f32x4*)(q_ + 4); n##w0 = *(const LAS f32x4*)(q_ + 64); n##w1 = *(const LAS f32x4*)(q_ + 68); \
    n##b0 = *(const LAS f32x4*)(q_ + 128); n##b1 = *(const LAS f32x4*)(q_ + 132); n##p0 = *(const LAS f32x4*)(q_ + 192); n##p1 = *(const LAS f32x4*)(q_ + 196); \
    n##r0 = *(const LAS f32x4*)(q_ + 256); n##r1 = *(const LAS f32x4*)(q_ + 260); \
    n##vA = qs_[320 + rowA]; n##vB = qs_[328 + rowA]; n##cc = *(const LAS f32x2*)(qs_ + 384); } while (0)
#define RSTEP_DO(n, yrow) rstep_do(n##k0, n##k1, n##w0, n##w1, n##b0, n##b1, n##p0, n##p1, n##r0, n##r1, n##vA, n##vB, n##cc, SA, SB, (yrow))
DI void rstep_do(const f32x4 k0, const f32x4 k1, const f32x4 w0, const f32x4 w1, const f32x4 b0, const f32x4 b1, const f32x4 p0, const f32x4 p1, const f32x4 r0, const f32x4 r1,
                 const float vA, const float vB, const f32x2 cc, f32x2 (&SA)[4], f32x2 (&SB)[4], LAS float* yrow) {
    const f32x2 kk[4] = {(f32x2){k0[0], k0[1]}, (f32x2){k0[2], k0[3]}, (f32x2){k1[0], k1[1]}, (f32x2){k1[2], k1[3]}};
    const f32x2 ww[4] = {(f32x2){w0[0], w0[1]}, (f32x2){w0[2], w0[3]}, (f32x2){w1[0], w1[1]}, (f32x2){w1[2], w1[3]}};
    const f32x2 bb[4] = {(f32x2){b0[0], b0[1]}, (f32x2){b0[2], b0[3]}, (f32x2){b1[0], b1[1]}, (f32x2){b1[2], b1[3]}};
    const f32x2 kp[4] = {(f32x2){p0[0], p0[1]}, (f32x2){p0[2], p0[3]}, (f32x2){p1[0], p1[1]}, (f32x2){p1[2], p1[3]}};
    const f32x2 wr[4] = {(f32x2){r0[0], r0[1]}, (f32x2){r0[2], r0[3]}, (f32x2){r1[0], r1[1]}, (f32x2){r1[2], r1[3]}};
    f32x2 a1 = SA[0] * kk[0], a2 = SA[0] * wr[0], c1 = SB[0] * kk[0], c2 = SB[0] * wr[0];
#pragma unroll
    for (int i = 1; i < 4; ++i) { a1 += SA[i] * kk[i]; a2 += SA[i] * wr[i]; c1 += SB[i] * kk[i]; c2 += SB[i] * wr[i]; }
    const float P1A = dpp_sum8(a1.x + a1.y), P1B = dpp_sum8(c1.x + c1.y);
#pragma unroll
    for (int i = 0; i < 4; ++i) {
        SA[i] = SA[i] * ww[i] + (kp[i] * vA - bb[i] * P1A);
        SB[i] = SB[i] * ww[i] + (kp[i] * vB - bb[i] * P1B);
    }
    const float P2A = dpp_sum8(a2.x + a2.y), P2B = dpp_sum8(c2.x + c2.y);
    yrow[0] = P2A - P1A * cc.x + vA * cc.y;
    yrow[8] = P2B - P1B * cc.x + vB * cc.y;
}
__device__ __forceinline__ void rwkv_scan(PP p, LAS unsigned char* lds, const int wv) {
    const int tid = opaque_tid(wv), wid = wv, lane = tid & 63;
    LAS float* vec = (LAS float*)lds;
    LAS float* ybuf = (LAS float*)(lds + 114688);
    LAS float* bon = (LAS float*)(lds + 131072);
    unsigned char* ws = p->ws;
    const bool scanw = wid < 4;
    const int rg = lane >> 3, kq = lane & 7, rowA = 16 * (wid & 3) + rg;
    const int htid = tid & 255, pt = htid >> 3, c8 = (htid & 7) * 8;
    const int G = gridDim.x;
    int u, ustep, uend = 128 + 4096;
    if (G >= 256) { if ((int)blockIdx.x < 128) { u = blockIdx.x; ustep = 1 << 30; uend = 128; } else { u = 128 + (blockIdx.x - 128); ustep = G - 128; } }
    else { u = blockIdx.x; ustep = G; }
    RwkvJob pend; pend.nt = 0; pend.row_base = 0; pend.t0 = 0; pend.hd = 0; pend.buf = 0;
    for (; u < uend; u += ustep) {
        const bool pr = u < 128; int b, hd, row_base, T;
        if (pr) { b = u >> 5; hd = u & 31; row_base = b * 2048; T = 2048; } else { const int s = u - 128; b = s >> 5; hd = s & 31; row_base = MPR + b * 8; T = 8; }
        const int nb = (T + 31) >> 5;
        const size_t sofs = (size_t)(b * 32 + hd) * 4096 + rowA * 64 + 8 * kq;
        f32x2 SA[4], SB[4];
        if (scanw) {
            if (pr) {
#pragma unroll
                for (int j = 0; j < 4; ++j) { SA[j] = (f32x2){0.f, 0.f}; SB[j] = (f32x2){0.f, 0.f}; }
            } else {
                const f32x4 a0 = __builtin_nontemporal_load((const f32x4*)(p->in[I_RS] + sofs)), a1 = __builtin_nontemporal_load((const f32x4*)(p->in[I_RS] + sofs + 4));
                const f32x4 b0 = __builtin_nontemporal_load((const f32x4*)(p->in[I_RS] + sofs + 512)), b1 = __builtin_nontemporal_load((const f32x4*)(p->in[I_RS] + sofs + 516));
                SA[0] = (f32x2){a0[0], a0[1]}; SA[1] = (f32x2){a0[2], a0[3]}; SA[2] = (f32x2){a1[0], a1[1]}; SA[3] = (f32x2){a1[2], a1[3]};
                SB[0] = (f32x2){b0[0], b0[1]}; SB[1] = (f32x2){b0[2], b0[3]}; SB[2] = (f32x2){b1[0], b1[1]}; SB[3] = (f32x2){b1[2], b1[3]};
            }
        } else {
            if (pend.nt > 0) rwkv_post(p, vec, ybuf, bon, pend, pt, c8, ws);
            RwkvJob jb; jb.row_base = row_base; jb.t0 = 0; jb.nt = T < 32 ? T : 32; jb.hd = hd; jb.buf = 0;
            rwkv_prep(p, vec, bon, jb, pt, c8, ws);
        }
        __syncthreads();
        for (int j = 0; j < nb; ++j) {
            const int t0 = j * 32, nt = (T - t0) < 32 ? (T - t0) : 32;
            if (scanw) {
                const LAS float* vt = vec + (j & 1) * (32 * 448) + 8 * kq;
                LAS float* yb = ybuf + (j & 1) * (32 * 64);
                const LAS float* vs0 = vec + (j & 1) * (32 * 448);
                RSTEP_DECL(s0); RSTEP_DECL(s1); RSTEP_LOAD(s0, vt, vs0);
                for (int t = 0; t < nt; t += 4) {
                    const LAS float* vtb = vt + t * 448; const LAS float* vsb = vs0 + t * 448; LAS float* ybb = yb + t * 64 + rowA;
                    RSTEP_LOAD(s1, vtb + 448, vsb + 448);
                    RSTEP_DO(s0, ybb);
                    RSTEP_LOAD(s0, vtb + 2 * 448, vsb + 2 * 448);
                    RSTEP_DO(s1, ybb + 64);
                    RSTEP_LOAD(s1, vtb + 3 * 448, vsb + 3 * 448);
                    RSTEP_DO(s0, ybb + 128);
                    const int tn = (t + 4 < nt) ? 4 : 3;
                    RSTEP_LOAD(s0, vtb + tn * 448, vsb + tn * 448);
                    RSTEP_DO(s1, ybb + 192);
                }
            } else {
                if (j >= 1) { RwkvJob jp; jp.row_base = row_base; jp.t0 = t0 - 32; jp.nt = 32; jp.hd = hd; jp.buf = (j - 1) & 1; rwkv_post(p, vec, ybuf, bon, jp, pt, c8, ws); }
                if (j + 1 < nb) { RwkvJob jn; jn.row_base = row_base; jn.t0 = t0 + 32; jn.nt = (T - t0 - 32) < 32 ? (T - t0 - 32) : 32; jn.hd = hd; jn.buf = (j + 1) & 1; rwkv_prep(p, vec, bon, jn, pt, c8, ws); }
            }
            __syncthreads();
        }
        pend.row_base = row_base; pend.t0 = (nb - 1) * 32; pend.nt = T - (nb - 1) * 32; pend.hd = hd; pend.buf = (nb - 1) & 1;
        if (scanw) {
            float* So = p->out + (pr ? O_SP : O_SS) + sofs;
            __builtin_nontemporal_store((f32x4){SA[0].x, SA[0].y, SA[1].x, SA[1].y}, (f32x4*)So); __builtin_nontemporal_store((f32x4){SA[2].x, SA[2].y, SA[3].x, SA[3].y}, (f32x4*)(So + 4));
            __builtin_nontemporal_store((f32x4){SB[0].x, SB[0].y, SB[1].x, SB[1].y}, (f32x4*)(So + 512)); __builtin_nontemporal_store((f32x4){SB[2].x, SB[2].y, SB[3].x, SB[3].y}, (f32x4*)(So + 516));
        }
    }
    if (!scanw && pend.nt > 0) rwkv_post(p, vec, ybuf, bon, pend, pt, c8, ws);
    __syncthreads();
}

__device__ __forceinline__ void final_norm(PP p, const int wv) {
    const u16* h = (const u16*)(p->ws + OFF_H); const float* ssq = (const float*)(p->ws + OFF_SSQ) + 4 * MT; const float* g = p->in[I_NFIN];
    const int n4 = MT * D / 4;
    const int tid = opaque_tid(wv);
    for (int i = blockIdx.x * 512 + tid; i < n4; i += gridDim.x * 512) {
        const int row = i >> 9, c = (i & 511) * 4;
        const float rs = rsqrtf(ssq[row] * (1.0f / D) + NEPS);
        const f32x4 v = ld_bf16x4(h + (size_t)i * 4), gg = *(const f32x4*)(g + c);
        __builtin_nontemporal_store(v * rs * gg, (f32x4*)(p->out + O_Y + (size_t)i * 4));
    }
}

DI unsigned xcc_id() { return (unsigned)__builtin_amdgcn_s_getreg(20 | (3 << 11)) & 7u; }
DI void grid_bar(unsigned* ctl, const unsigned epoch, const unsigned nx, const unsigned nxcc, const int wv) {
    typedef __attribute__((address_space(1))) unsigned gu32;
    __syncthreads();
    if (opaque_tid(wv) == 0) {
        const unsigned x = xcc_id();
        const unsigned old = __hip_atomic_fetch_add((gu32*)(ctl + 64 * x), 1u, __ATOMIC_RELAXED, __HIP_MEMORY_SCOPE_AGENT);
        if (old + 1u == nx * epoch) {
            __builtin_amdgcn_fence(__ATOMIC_RELEASE, "agent");
            asm volatile("s_waitcnt vmcnt(0)" ::: "memory");
            __hip_atomic_fetch_add((gu32*)(ctl + 512), 1u, __ATOMIC_RELAXED, __HIP_MEMORY_SCOPE_AGENT);
            while (__hip_atomic_load((gu32*)(ctl + 512), __ATOMIC_RELAXED, __HIP_MEMORY_SCOPE_AGENT) < nxcc * epoch) __builtin_amdgcn_s_sleep(1);
            __hip_atomic_store((gu32*)(ctl + 640 + 16 * x), epoch, __ATOMIC_RELAXED, __HIP_MEMORY_SCOPE_AGENT);
        } else {
            while (__hip_atomic_load((gu32*)(ctl + 640 + 16 * x), __ATOMIC_RELAXED, __HIP_MEMORY_SCOPE_AGENT) < epoch) __builtin_amdgcn_s_sleep(1);
        }
        __builtin_amdgcn_fence(__ATOMIC_ACQUIRE, "agent");
        asm volatile("s_waitcnt vmcnt(0)" ::: "memory");
    }
    __syncthreads();
}
#ifndef EN_MASK
#define EN_MASK 0xFFFF
#endif
#define EN(k) ((EN_MASK >> (k)) & 1)
#ifndef DUP_MASK
#define DUP_MASK 0
#endif
#define DUP(k) ((DUP_MASK >> (k)) & 1)
__global__ void __launch_bounds__(512, 2) mega(Params p_unused) {
    const PP kp = (PP)__builtin_amdgcn_kernarg_segment_ptr();
    const int wv = __builtin_amdgcn_readfirstlane((int)(threadIdx.x >> 6));
    extern __shared__ __attribute__((aligned(16))) unsigned char smem_raw[];
    LAS unsigned char* lds = (LAS unsigned char*)smem_raw;
    cg::grid_group grid = cg::this_grid();
    const int G = gridDim.x, cid = blockIdx.x;
    const int ph_lo = kp->ph_lo, ph_hi = kp->ph_hi;
    int ph = 0; unsigned nbar = 0, nx_ = 1, nxcc_ = 1;
    if (opaque_tid(wv) == 0) { typedef __attribute__((address_space(1))) unsigned gu32; __hip_atomic_fetch_add((gu32*)((unsigned*)(kp->ws + OFF_CNT) + 576 + xcc_id()), 1u, __ATOMIC_RELAXED, __HIP_MEMORY_SCOPE_AGENT); }
#define PHASE_BEGIN if (ph >= ph_lo && ph < ph_hi) { const PP p = launder(kp); unsigned char* ws = p->ws; u16* h = (u16*)(ws + OFF_H); float* ssq = (float*)(ws + OFF_SSQ); const char* big = (const char*)(ws + OFF_BIG); (void)h; (void)ssq; (void)big;
#define PHASE_END   } ++ph; if (ph > ph_lo && ph < ph_hi) { ++nbar; grid_bar((unsigned*)(kp->ws + OFF_CNT), nbar, nx_, nxcc_, wv); }
#define PHASE_END_CG } ++ph; if (ph > ph_lo && ph < ph_hi) { grid.sync(); \
        { typedef __attribute__((address_space(1))) unsigned gu32; gu32* cen = (gu32*)((unsigned*)(kp->ws + OFF_CNT) + 576); nxcc_ = 0; \
          for (int x_ = 0; x_ < 8; ++x_) nxcc_ += (__hip_atomic_load(cen + x_, __ATOMIC_RELAXED, __HIP_MEMORY_SCOPE_AGENT) != 0u) ? 1u : 0u; \
          nx_ = __hip_atomic_load(cen + xcc_id(), __ATOMIC_RELAXED, __HIP_MEMORY_SCOPE_AGENT); nx_ = (unsigned)__builtin_amdgcn_readfirstlane((int)nx_); nxcc_ = (unsigned)__builtin_amdgcn_readfirstlane((int)nxcc_); } }

    PHASE_BEGIN { int nrep = DUP(0) ? 2 : 1; asm volatile("" : "+s"(nrep)); for (int rep = 0; rep < nrep; ++rep) { if (EN(0)) phase0(p, lds, wv); __syncthreads(); } } PHASE_END_CG
    PHASE_BEGIN
    {
        pg8::MultiOrder<pg8::Sub1> S; S.sub = {big, (const char*)(ws + OFF_W_IN0), 25}; S.K = D; S.nM = MT / 256; S.G = G; S.c = cid;
        EpiMlstmIn E{(u16*)(ws + OFF_BIG + SZ_ACT), (u16*)(ws + OFF_BIG + SZ_ACT + SZ_ACT / 2), (u16*)(ws + OFF_BIG + 2 * SZ_ACT), (u16*)(ws + OFF_BIG + 3 * SZ_ACT),
                     (float*)(ws + OFF_LG), (float*)(ws + OFF_LG) + (size_t)MT * 8, p->in[I_MBIG], p->in[I_MBFG]};
        if (EN(1)) pg8::gemm_phase(lds, D, S, E, wv);
        pg8::MultiOrder<pg8::Sub1> S2; S2.sub = {(const char*)(ws + OFF_AP), (const char*)(ws + OFF_W_PP), 8}; S2.K = 256; S2.nM = MT / 256; S2.G = G; S2.c = (cid + 132) % G;
        EpiLora2 E2{nullptr, nullptr, nullptr, (u16*)(ws + OFF_PPB), nullptr, nullptr, 3};
        int K2 = 256; asm volatile("" : "+s"(K2)); S2.K = K2;
        if (EN(2)) pg8::gemm_phase(lds, K2, S2, E2, wv);
    }
    PHASE_END
    PHASE_BEGIN { int nrep = DUP(3) ? 2 : 1; asm volatile("" : "+s"(nrep)); for (int rep = 0; rep < nrep; ++rep) { if (EN(3)) mlstm_scan(p, lds, wv); __syncthreads(); } { int rank, nb; if (G > 64) { rank = cid - 32; nb = G - 32; } else { rank = cid; nb = G; } if (rank >= 0) convert_group(p, lds, wv, 1, rank, nb); } } PHASE_END
#pragma unroll 1
    for (int layer = 0; layer < 2; ++layer) {
        if (layer == 1) {
            PHASE_BEGIN if (EN(4)) rwkv_norm_mix(p, wv); PHASE_END
            PHASE_BEGIN
            {
                pg8::MultiOrder<pg8::SubRwkvIn> S; S.sub = {big, (const char*)(ws + OFF_W_IN1)};
                S.K = D; S.nM = MT / 256; S.G = G; S.c = cid;
                EpiRwkvIn E{(u16*)(ws + OFF_BIG + 6 * SZ_ACT), (u16*)(ws + OFF_LORA)};
                if (EN(5)) pg8::gemm_phase(lds, D, S, E, wv);
            }
            PHASE_END
            PHASE_BEGIN
            {
                pg8::MultiOrder<pg8::SubLora2> S; S.sub = {(const char*)(ws + OFF_LORA), (const char*)(ws + OFF_W_L2), (const char*)(ws + OFF_AP) + (size_t)MT * 512, (const char*)(ws + OFF_W_PP + SZ_W_PP)};
                S.K = 256; S.nM = MT / 256; S.G = G; S.c = cid;
                EpiLora2 E{(float*)(ws + OFF_BIG), (float*)(ws + OFF_BIG + 2 * SZ_ACT), (u16*)(ws + OFF_BIG + 4 * SZ_ACT), (u16*)(ws + OFF_PPB), p->in[I_RW0], p->in[I_RA0], 0};
                int K2 = 256; asm volatile("" : "+s"(K2)); S.K = K2;
                if (EN(6)) pg8::gemm_phase(lds, K2, S, E, wv);
            }
            PHASE_END
            PHASE_BEGIN { int nrep = DUP(7) ? 2 : 1; asm volatile("" : "+s"(nrep)); for (int rep = 0; rep < nrep; ++rep) { if (EN(7)) rwkv_scan(p, lds, wv); __syncthreads(); } { int rank, nb; if (G >= 256) { rank = cid - 128; nb = G - 128; } else { rank = cid; nb = G; } if (rank >= 0) convert_group(p, lds, wv, 2, rank, nb); } } PHASE_END
        }
#pragma unroll 1
        for (int r = 0; r < 2; ++r) {
            PHASE_BEGIN
            {
                pg8::SplitOrder S; S.G = G; S.c = cid; S.part = (float*)(ws + OFF_BIG + 6 * SZ_ACT); S.cnt = (unsigned*)(ws + OFF_CNT);
                int K;
                if (r == 0) { S.A = big + 5 * SZ_ACT; S.B = (const char*)(ws + (layer ? OFF_W_OUT1 : OFF_W_OUT0)); K = D; S.nsp = -1; }
                else { S.A = big + SZ_ACT; S.B = (const char*)(ws + OFF_W_DN + layer * SZ_W_DN); K = DFF; S.nsp = -1; }
                S.K = K;
                EpiResid E{h, ssq + (size_t)(layer * 2 + r) * MT, (r == 0 ? p->in[I_NFFN] : p->in[I_NPLE]) + layer * D, (u16*)(ws + OFF_BIG + (r == 0 ? 0 : 5 * SZ_ACT))};
                if (EN(8)) pg8::gemm_phase(lds, K, S, E, wv);
                {
                    EpiResidS ES{h, ssq + (size_t)(layer * 2 + r) * MT, (r == 0 ? p->in[I_NFFN] : p->in[I_NPLE]) + layer * D, (u16*)(ws + OFF_BIG + (r == 0 ? 0 : 5 * SZ_ACT))};
                    sgemm_sample(lds, (const u16*)S.A + (size_t)MPR * K, (const u16*)S.B, K, ES, wv);
                }
            }
            PHASE_END
            if (r == 0) {
                PHASE_BEGIN
                {
                    pg8::MultiOrder<pg8::Sub1> S; S.sub = {big, (const char*)(ws + OFF_W_GU + layer * SZ_W_GU), 44}; S.K = D; S.nM = MT / 256; S.G = G; S.c = cid; S.Lmax = 1536;
                    EpiSwiglu E{ssq + (size_t)(layer * 2) * MT, (u16*)(ws + OFF_BIG + SZ_ACT)};
                    if (EN(9)) pg8::gemm_phase(lds, D, S, E, wv);
                    for (int q = cid; q < 192; q += G) {
                        pg8::Unit uq; S.unit_at(1536 + (q >> 2), uq);
                        sgemm_swiglu_tile(lds, (const u16*)big, (const u16*)(ws + OFF_W_GU + layer * SZ_W_GU), ssq + (size_t)(layer * 2) * MT, (u16*)(ws + OFF_BIG + SZ_ACT), wv, uq.pm * 256 + ((q >> 1) & 1) * 128, uq.pn * 128 + (q & 1) * 64);
                    }
                }
                PHASE_END
            }
        }
        PHASE_BEGIN
        {
            pg8::SplitOrder S; S.G = G; S.c = cid; S.part = (float*)(ws + OFF_BIG + 6 * SZ_ACT); S.cnt = (unsigned*)(ws + OFF_CNT); S.A = big + 5 * SZ_ACT; S.B = (const char*)(ws + OFF_W_PG + layer * SZ_SQ); S.K = D; S.nsp = -1;
            EpiPle E{ssq + (size_t)(layer * 2 + 1) * MT, (const u16*)(ws + OFF_PPB), h, layer ? ssq + 4 * MT : nullptr};
            if (EN(10)) pg8::gemm_phase(lds, D, S, E, wv);
            {
                EpiPleS ES{ssq + (size_t)(layer * 2 + 1) * MT, (const u16*)(ws + OFF_PPB), h, layer ? ssq + 4 * MT : nullptr};
                sgemm_sample(lds, (const u16*)S.A + (size_t)MPR * D, (const u16*)S.B, D, ES, wv);
            }
        }
        PHASE_END
    }
    PHASE_BEGIN if (EN(11)) final_norm(p, wv); PHASE_END
}

extern "C" void kernel_launch(void* const* d_in, const int* in_sizes, int n_in, void* d_out, int out_size, void* d_ws, size_t ws_size, hipStream_t stream) {
    static int grid = 0;
    if (!grid) {
        int dev = 0, cus = 0, per_cu = 0;
        hipGetDevice(&dev);
        hipDeviceGetAttribute(&cus, hipDeviceAttributeMultiprocessorCount, dev);
        hipFuncSetAttribute((const void*)mega, hipFuncAttributeMaxDynamicSharedMemorySize, LDS_BYTES);
        hipOccupancyMaxActiveBlocksPerMultiprocessor(&per_cu, (const void*)mega, 512, LDS_BYTES);
        if (per_cu < 1) per_cu = 1;
        grid = cus * per_cu;
        if (ws_size < WS_NEED) fprintf(stderr, "kernel_launch: workspace too small: %zu < %zu\n", ws_size, (size_t)WS_NEED);
        if (n_in != N_IN) fprintf(stderr, "kernel_launch: expected %d inputs, got %d\n", (int)N_IN, n_in);
    }
    Params p{};
    for (int i = 0; i < N_IN; ++i) p.in[i] = (const float*)d_in[i];
    p.out = (float*)d_out; p.ws = (unsigned char*)d_ws; p.ph_lo = 0; p.ph_hi = NPH;
    (void)hipMemsetAsync((char*)d_ws + OFF_CNT, 0, 4096, stream);
    void* args[] = {&p};
    hipError_t e = hipLaunchCooperativeKernel((const void*)mega, dim3(grid), dim3(512), args, LDS_BYTES, stream);
    if (e != hipSuccess) fprintf(stderr, "cooperative launch failed: %s (grid %d)\n", hipGetErrorString(e), grid);
}
```

```cpp
#include <hip/hip_runtime.h>
#include <hip/hip_cooperative_groups.h>
#include <cstdio>
namespace cg = cooperative_groups;

#define LAS __attribute__((address_space(3)))
#define DI __device__ __forceinline__
typedef unsigned short u16;
typedef short bf16x8 __attribute__((ext_vector_type(8)));
typedef float f32x4 __attribute__((ext_vector_type(4)));
typedef float f32x16 __attribute__((ext_vector_type(16)));
typedef unsigned u32x4 __attribute__((ext_vector_type(4)));
typedef unsigned u32x2 __attribute__((ext_vector_type(2)));

constexpr int D = 2048, MT = 9216, MPR = 8192, DFF = 5632;
constexpr float NEPS = 1e-6f;
constexpr int LDS_BYTES = 147456;
constexpr int NPH = 16;

enum { I_XP = 0, I_XS, I_MC, I_MN, I_MM, I_RS, I_RSH, I_PP, I_PS, I_NMIX, I_NFFN, I_NPLE, I_NFIN, I_FG, I_FU, I_FD, I_PWP, I_PWG,
       I_MQ, I_MK, I_MV, I_MIG, I_MBIG, I_MFG, I_MBFG, I_MOG, I_MNW, I_MOUT, I_RMU, I_RWR, I_RWK, I_RWV, I_RWO, I_RW0, I_RW1, I_RW2,
       I_RA0, I_RA1, I_RA2, I_RG1, I_RG2, I_RKK, I_RKA, I_RRK, I_RLNW, I_RLNB, N_IN };

constexpr size_t O_Y = 0;
constexpr size_t O_CP = (size_t)MT * D;
constexpr size_t O_NP = O_CP + 1048576;
constexpr size_t O_MP = O_NP + 4096;
constexpr size_t O_SP = O_MP + 32;
constexpr size_t O_SHP = O_SP + 524288;
constexpr size_t O_CS = O_SHP + 8192;
constexpr size_t O_NS = O_CS + 33554432;
constexpr size_t O_MS = O_NS + 131072;
constexpr size_t O_SS = O_MS + 1024;
constexpr size_t O_SHS = O_SS + 16777216;

constexpr size_t SZ_ACT = (size_t)MT * D * 2;
constexpr size_t SZ_SQ = 2048ull * 2048 * 2;
constexpr size_t SZ_W_GU = 11264ull * 2048 * 2;
constexpr size_t SZ_W_DN = 2048ull * 5632 * 2;
constexpr size_t SZ_W_PP = 2048ull * 256 * 2;
constexpr size_t OFF_W_IN0 = 0;
constexpr size_t OFF_W_OUT0 = OFF_W_IN0 + 6400ull * 2048 * 2;
constexpr size_t OFF_W_GU = OFF_W_OUT0 + SZ_SQ;
constexpr size_t OFF_W_DN = OFF_W_GU + 2 * SZ_W_GU;
constexpr size_t OFF_W_PG = OFF_W_DN + 2 * SZ_W_DN;
constexpr size_t OFF_W_PP = OFF_W_PG + 2 * SZ_SQ;
constexpr size_t OFF_W_IN1 = OFF_W_PP + 2 * SZ_W_PP;
constexpr size_t OFF_W_L2 = OFF_W_IN1 + 6912ull * 2048 * 2;
constexpr size_t OFF_W_OUT1 = OFF_W_L2 + 3 * SZ_W_PP;
constexpr size_t OFF_H = OFF_W_OUT1 + SZ_SQ;
constexpr size_t OFF_PPB = OFF_H + (size_t)MT * D * 4;

constexpr size_t OFF_AP = OFF_PPB + SZ_ACT;
constexpr size_t OFF_SSQ = OFF_AP + 2ull * MT * 256 * 2;
constexpr size_t OFF_LG = OFF_SSQ + 5ull * MT * 4;
constexpr size_t OFF_CNT = OFF_LG + 2ull * MT * 8 * 4;
constexpr size_t OFF_LORA = OFF_CNT + 4096;
constexpr size_t OFF_BIG = OFF_LORA + 3ull * MT * 256 * 2;
constexpr size_t WS_NEED = OFF_BIG + 9 * SZ_ACT;

struct Params { const float* in[N_IN]; float* out; unsigned char* ws; int ph_lo, ph_hi; };
typedef const __attribute__((address_space(4))) Params* PP;
__device__ __forceinline__ PP launder(PP q) { asm volatile("" : "+s"(q)); return q; }

DI unsigned f2bf(float f) { unsigned u = __float_as_uint(f); u += 0x7FFFu + ((u >> 16) & 1u); return u >> 16; }
DI unsigned pk2(float lo, float hi) { return f2bf(lo) | (f2bf(hi) << 16); }
DI float bflo(unsigned w) { return __uint_as_float(w << 16); }
DI float bfhi(unsigned w) { return __uint_as_float(w & 0xFFFF0000u); }
DI unsigned cvt_pk_bf16(float lo, float hi) { unsigned r; asm volatile("v_cvt_pk_bf16_f32 %0, %1, %2" : "=v"(r) : "v"(lo), "v"(hi)); return r; }
DI f32x4 ld_bf16x4(const u16* p) { const u32x2 w = *(const u32x2*)p; return (f32x4){bflo(w.x), bfhi(w.x), bflo(w.y), bfhi(w.y)}; }
DI float sigm(float x) { return 1.0f / (1.0f + __expf(-x)); }
DI float fast_tanh(float x) { return 1.0f - 2.0f / (1.0f + __expf(2.0f * x)); }
DI float softcap15(float x) { return 15.0f * fast_tanh(x * (1.0f / 15.0f)); }
DI float softplus(float z) { return fmaxf(z, 0.f) + __logf(1.0f + __expf(-fabsf(z))); }
DI float wave_sum(float v) {
#pragma unroll
    for (int o = 32; o > 0; o >>= 1) v += __shfl_xor(v, o);
    return v;
}
DI float grp8_sum(float v) { v += __shfl_xor(v, 1); v += __shfl_xor(v, 2); v += __shfl_xor(v, 4); return v; }
DI float dppf(float x, const int ctrl_sel) {
    int xi = __float_as_int(x), r;
    if (ctrl_sel == 0) r = __builtin_amdgcn_update_dpp(0, xi, 0xB1, 0xF, 0xF, true);
    else if (ctrl_sel == 1) r = __builtin_amdgcn_update_dpp(0, xi, 0x4E, 0xF, 0xF, true);
    else r = __builtin_amdgcn_update_dpp(0, xi, 0x141, 0xF, 0xF, true);
    return __int_as_float(r);
}
DI float dpp_sum8(float x) { x += dppf(x, 0); x += dppf(x, 1); x += dppf(x, 2); return x; }
DI int opaque_tid(int wv) { int l = __builtin_amdgcn_mbcnt_hi(~0u, __builtin_amdgcn_mbcnt_lo(~0u, 0u)); asm volatile("" : "+v"(l)); return wv * 64 + l; }
DI int crow(int reg, int h) { return (reg & 3) + 8 * (reg >> 2) + 4 * h; }

namespace pg8 {
constexpr int BM = 256, BK = 64, HALF = 128, HTB = HALF * BK * 2, STAGE_BYTES = 8 * HTB, NXCD = 8, WGM = 8;
DI int lds_byte(int r, int c) { const int st = (r >> 4) * 2 + (c >> 5), rr = r & 15, cc = c & 31, ob = rr * 64 + cc * 2; return st * 1024 + (ob ^ (((ob >> 9) & 1) << 5)); }
DI void stage_rc(int b, int& R, int& C) { const int st = b / 1024, sb = b % 1024, swz = sb ^ (((sb >> 9) & 1) << 5); R = (st >> 1) * 16 + swz / 64; C = (st & 1) * 32 + (swz % 64) / 2; }
DI int perm32(int rho) { const int n = rho >> 4, i = rho & 15; return 8 * (i >> 2) + 4 * n + (i & 3); }

struct Unit { const char* A; const char* B; int pm, pn, g, nt, ks, nsp, tu, rb, hm; };
constexpr int NM = 36;
struct Sub1 { const char* A; const char* B; int nN;
    DI void locate(int& L, int& j, const char*& a, const char*& b, int& n) const { j = 0; a = A; b = B; n = nN; } };
struct SubRwkvIn { const char* A; const char* B;
    DI void locate(int& L, int& j, const char*& a, const char*& b, int& n) const {
        constexpr int n8 = NM * 8;
        if (L < 3 * n8) { j = L / n8; L -= j * n8; n = 8; b = B + (size_t)j * 2048 * D * 2; }
        else { L -= 3 * n8; int q = L / NM; if (q > 2) { q = 2; L = NM; } else L -= q * NM; j = 3 + q; n = 1; b = B + (size_t)(6144 + 256 * q) * D * 2; }
        a = A + (size_t)j * SZ_ACT; } };
struct SubLora2 { const char* LA; const char* LB; const char* PA; const char* PB;
    DI void locate(int& L, int& j, const char*& a, const char*& b, int& n) const {
        constexpr int n8 = NM * 8; int q = L / n8; if (q > 3) { q = 3; L = n8; } else L -= q * n8; j = q; n = 8;
        a = (q < 3) ? LA + (size_t)q * MT * 512 : PA; b = (q < 3) ? LB + (size_t)q * SZ_W_PP : PB; } };
template <class Sub> struct MultiOrder {
    Sub sub; int K, nM, G, c; int Lmax = 1 << 30;
    DI bool next(int i, Unit& u) const { const int L0 = i * G + c; if (L0 >= Lmax) return false; return unit_at(L0, u); }
    DI bool unit_at(int L, Unit& u) const {
        int j, nN; const char* A; const char* B;
        sub.locate(L, j, A, B, nN);
        const int nwg = NM * nN;
        if (L >= nwg) return false;
        int wgid = L; { const int q = nwg / NXCD, r = nwg % NXCD, xcd = wgid % NXCD, off = wgid / NXCD; wgid = (xcd < r ? xcd * (q + 1) : r * (q + 1) + (xcd - r) * q) + off; }
        const int nig = WGM * nN, gid = wgid / nig, fm = gid * WGM, gsz = (NM - fm) < WGM ? (NM - fm) : WGM;
        u.pm = fm + ((wgid % nig) % gsz); u.pn = (wgid % nig) / gsz; u.g = j; u.nt = K / BK; u.ks = 0; u.nsp = 1; u.tu = 0; u.rb = u.pm * 256; u.hm = 0;
        const size_t tstep = (size_t)BM * K * 2;
        u.A = A + (size_t)u.pm * tstep; u.B = B + (size_t)u.pn * tstep;
        return true;
    }
    DI bool finish(f32x4 (&acc)[2][2][4][2], const Unit& u, int wid, int lane) const { return true; }
};
struct SplitOrder {
    const char* A; const char* B; float* part; unsigned* cnt; int K, nsp, G, c;
    DI bool next(int i, Unit& u) const {
        int L = i * G + c; const size_t tstep = (size_t)BM * K * 2;
        if (L < 256) {
            const int wg = (L & 7) * 32 + (L >> 3), fm = (wg >> 6) * 8;
            u.pm = fm + ((wg & 63) & 7); u.pn = (wg & 63) >> 3; u.g = 0; u.nt = K / BK; u.ks = 0; u.nsp = 1; u.tu = 0; u.rb = u.pm * 256; u.hm = 0;
            u.A = A + (size_t)u.pm * tstep; u.B = B + (size_t)u.pn * tstep; return true;
        }
        L -= 256;
        if (nsp < 0) return false;
        if (nsp == 0) {
            if (L >= 64) return false;
            const int tu = L >> 1, hh = L & 1;
            u.pm = 32 + (tu & 3); u.pn = tu >> 2; u.g = 0; u.nt = K / BK; u.ks = 0; u.nsp = 1; u.tu = tu; u.rb = u.pm * 256 + hh * 128; u.hm = 1;
            u.A = A + (size_t)u.rb * K * 2; u.B = B + (size_t)u.pn * tstep; return true;
        }
        if (L >= 32 * nsp) return false;
        const int tu = L / nsp, ks = L - tu * nsp, kc = K / nsp;
        u.pm = 32 + (tu & 3); u.pn = tu >> 2; u.g = 0; u.nt = kc / BK; u.ks = ks; u.nsp = nsp; u.tu = tu; u.rb = u.pm * 256; u.hm = 0;
        u.A = A + (size_t)u.pm * tstep + (size_t)ks * kc * 2; u.B = B + (size_t)u.pn * tstep + (size_t)ks * kc * 2; return true;
    }
    DI bool finish(f32x4 (&acc)[2][2][4][2], const Unit& u, int wid, int lane) const {
        if (u.nsp == 1) return true;
        typedef __attribute__((address_space(1))) unsigned gu32;
        const __amdgpu_buffer_rsrc_t rs = __builtin_amdgcn_make_buffer_rsrc((void*)part, (short)0, 32 * 8 * 8 * 8192 * 4, 0x00020000);
        const unsigned base = (unsigned)(((u.tu * nsp) * 8 + wid) * 8192 + lane * 4) * 4u;
        {
            unsigned q = base + (unsigned)u.ks * (8u * 8192u * 4u);
#pragma unroll
            for (int f = 0; f < 32; ++f) {
                __builtin_amdgcn_raw_buffer_store_b128(__builtin_bit_cast(u32x4, acc[f >> 4][(f >> 3) & 1][(f >> 1) & 3][f & 1]), rs, q, 0, 16);
                q += 1024u;
            }
        }
        asm volatile("s_waitcnt vmcnt(0)" ::: "memory");
        unsigned old = 0;
        if (lane == 0) old = __hip_atomic_fetch_add((gu32*)(cnt + u.tu * 8 + wid), 1u, __ATOMIC_RELAXED, __HIP_MEMORY_SCOPE_AGENT);
        old = (unsigned)__builtin_amdgcn_readfirstlane((int)old);
        if (old != (unsigned)(nsp - 1)) return false;
#pragma unroll
        for (int f = 0; f < 32; ++f) acc[f >> 4][(f >> 3) & 1][(f >> 1) & 3][f & 1] = (f32x4){0.f, 0.f, 0.f, 0.f};
#pragma unroll 1
        for (int sp = 0; sp < nsp; ++sp) {
            unsigned q = base + (unsigned)sp * (8u * 8192u * 4u);
#pragma unroll
            for (int f = 0; f < 32; ++f) {
                acc[f >> 4][(f >> 3) & 1][(f >> 1) & 3][f & 1] += __builtin_bit_cast(f32x4, __builtin_amdgcn_raw_buffer_load_b128(rs, q, 0, 16));
                q += 1024u;
            }
        }
        if (lane == 0) __hip_atomic_store((gu32*)(cnt + u.tu * 8 + wid), 0u, __ATOMIC_RELAXED, __HIP_MEMORY_SCOPE_AGENT);
        return true;
    }
};

template <class Epi, class Sched>
DI void gemm_phase(LAS unsigned char* lds, const int K, const Sched& S, const Epi& E, const int wv) {
    const int tid = opaque_tid(wv), wid = __builtin_amdgcn_readfirstlane(tid >> 6), lane = tid & 63, wr = wid >> 2, wc = wid & 3, fr = lane & 15, fq = lane >> 4;
    unsigned voffA[2], voffB[2];
#pragma unroll
    for (int i = 0; i < 2; ++i) { int R, C; stage_rc(tid * 16 + i * 8192, R, C); const int Rb = (R & ~31) + perm32(R & 31);
        voffA[i] = (unsigned)(R * K + C) * 2u; voffB[i] = (unsigned)(Rb * K + C) * 2u; }
    const size_t kstep = (size_t)(BK * 2);
    const size_t hstep = (size_t)HALF * K * 2;
    const unsigned ldsw = (unsigned)wid * 1024u;
    const int aoff = lds_byte(wr * 64 + fr, fq * 8), boff = lds_byte(wc * 32 + fr, fq * 8);
#define PG8_SA(b, h) (((b) * 2 + (h)) * HTB)
#define PG8_SB(b, h) ((4 + (b) * 2 + (h)) * HTB)
#define PG8_STAGE(bufoff, gbase, voff) do { _Pragma("unroll") for (int _i = 0; _i < 2; ++_i) \
        __builtin_amdgcn_global_load_lds((const unsigned*)((const char*)(gbase) + (voff)[_i]), (LAS unsigned*)(lds + (bufoff) + ldsw + _i * 8192), 16, 0, 0); } while (0)
#define PG8_LDA(dst, b, h) do { _Pragma("unroll") for (int m = 0; m < 4; ++m) _Pragma("unroll") for (int k = 0; k < 2; ++k) dst[m][k] = *(const LAS bf16x8*)(lds + PG8_SA(b, h) + aoff + m * 2048 + k * 1024); } while (0)
#define PG8_LDB(dst, b, h) do { _Pragma("unroll") for (int n = 0; n < 2; ++n) _Pragma("unroll") for (int k = 0; k < 2; ++k) dst[n][k] = *(const LAS bf16x8*)(lds + PG8_SB(b, h) + boff + n * 2048 + k * 1024); } while (0)
#define PG8_MMA(ai, bj, At, Bt) do { __builtin_amdgcn_s_setprio(1); _Pragma("unroll") for (int m = 0; m < 4; ++m) _Pragma("unroll") for (int n = 0; n < 2; ++n) _Pragma("unroll") for (int k = 0; k < 2; ++k) \
        acc[ai][bj][m][n] = __builtin_amdgcn_mfma_f32_16x16x32_bf16(Bt[n][k], At[m][k], acc[ai][bj][m][n], 0, 0, 0); __builtin_amdgcn_s_setprio(0); } while (0)
#define PG8_WAIT_V(n) asm volatile("s_waitcnt vmcnt(" #n ")" ::: "memory")
#define PG8_WAIT_L(n) asm volatile("s_waitcnt lgkmcnt(" #n ")" ::: "memory")
#define PG8_BAR __builtin_amdgcn_s_barrier()
#define PG8_SCHED __builtin_amdgcn_sched_barrier(0)
    Unit cur, nxt; int ui = 0;
    if (!S.next(0, cur)) return;
    f32x4 acc[2][2][4][2];
#pragma unroll
    for (int a = 0; a < 2; ++a)
#pragma unroll
        for (int b = 0; b < 2; ++b)
#pragma unroll
            for (int m = 0; m < 4; ++m)
#pragma unroll
                for (int n = 0; n < 2; ++n) acc[a][b][m][n] = (f32x4){0.f, 0.f, 0.f, 0.f};
    bf16x8 At[4][2], B0[2][2], B1[2][2];
    const char* cA = cur.A; const char* cB = cur.B;
    PG8_STAGE(PG8_SB(0, 0), cB, voffB); PG8_STAGE(PG8_SA(0, 0), cA, voffA); PG8_STAGE(PG8_SB(0, 1), cB + hstep, voffB); PG8_STAGE(PG8_SA(0, 1), cA + hstep, voffA);
    if (wr == 1) PG8_BAR;
    PG8_WAIT_V(4); PG8_BAR;
    PG8_STAGE(PG8_SB(1, 0), cB + kstep, voffB); PG8_STAGE(PG8_SA(1, 0), cA + kstep, voffA); PG8_STAGE(PG8_SB(1, 1), cB + hstep + kstep, voffB);
    PG8_WAIT_V(6); PG8_BAR;
    for (;;) {
        const bool has_next = S.next(ui + 1, nxt);
        const char* nA = has_next ? nxt.A : cA; const char* nB = has_next ? nxt.B : cB;
        const int nt = cur.nt; constexpr bool hm = false;
        for (int t = 0; t < nt; t += 2) {
            const bool last = (t == nt - 2);
            const char* a1 = cA + (size_t)(t + 1) * kstep;
            const char* a2 = last ? nA : cA + (size_t)(t + 2) * kstep; const char* b2 = last ? nB : cB + (size_t)(t + 2) * kstep;
            const char* a3 = a2 + kstep; const char* b3 = b2 + kstep;
            PG8_LDB(B0, 0, 0); PG8_SCHED; PG8_LDA(At, 0, 0); PG8_STAGE(PG8_SA(1, 1), a1 + hstep, voffA);
            PG8_WAIT_L(8); PG8_BAR; PG8_WAIT_L(0); PG8_MMA(0, 0, At, B0); PG8_BAR; PG8_SCHED;
            PG8_LDB(B1, 0, 1); PG8_STAGE(PG8_SB(0, 0), b2, voffB);
            PG8_BAR; PG8_WAIT_L(0); PG8_MMA(0, 1, At, B1); PG8_BAR;
            PG8_LDA(At, 0, 1); PG8_STAGE(PG8_SA(0, 0), a2, voffA);
            PG8_BAR; PG8_WAIT_L(0); if (!hm) PG8_MMA(1, 0, At, B0); PG8_BAR; PG8_SCHED;
            PG8_STAGE(PG8_SB(0, 1), b2 + hstep, voffB);
            PG8_WAIT_V(6); PG8_BAR; if (!hm) PG8_MMA(1, 1, At, B1); PG8_BAR;
            PG8_LDB(B0, 1, 0); PG8_SCHED; PG8_LDA(At, 1, 0); PG8_STAGE(PG8_SA(0, 1), a2 + hstep, voffA);
            PG8_WAIT_L(8); PG8_BAR; PG8_WAIT_L(0); PG8_MMA(0, 0, At, B0); PG8_BAR; PG8_SCHED;
            PG8_LDB(B1, 1, 1); PG8_STAGE(PG8_SB(1, 0), b3, voffB);
            PG8_BAR; PG8_WAIT_L(0); PG8_MMA(0, 1, At, B1); PG8_BAR;
            PG8_LDA(At, 1, 1); PG8_STAGE(PG8_SA(1, 0), a3, voffA);
            PG8_BAR; PG8_WAIT_L(0); if (!hm) PG8_MMA(1, 0, At, B0); PG8_BAR; PG8_SCHED;
            PG8_STAGE(PG8_SB(1, 1), b3 + hstep, voffB);
            PG8_WAIT_V(6); PG8_BAR; if (!hm) PG8_MMA(1, 1, At, B1); PG8_BAR;
        }
        if (S.finish(acc, cur, wid, lane)) E(acc, cur, wr, wc, fr, fq);
        if (!has_next) break;
#pragma unroll
        for (int a = 0; a < 2; ++a)
#pragma unroll
            for (int b = 0; b < 2; ++b)
#pragma unroll
                for (int m = 0; m < 4; ++m)
#pragma unroll
                    for (int n = 0; n < 2; ++n) acc[a][b][m][n] = (f32x4){0.f, 0.f, 0.f, 0.f};
        cur = nxt; cA = nA; cB = nB; ++ui;
    }
    PG8_WAIT_V(0);
    if (wr == 0) PG8_BAR;
    PG8_BAR;
#undef PG8_SA
#undef PG8_SB
#undef PG8_STAGE
#undef PG8_LDA
#undef PG8_LDB
#undef PG8_MMA
#undef PG8_WAIT_V
#undef PG8_WAIT_L
#undef PG8_BAR
#undef PG8_SCHED
}
}
using pg8::Unit;
typedef f32x4 AccT[2][2][4][2];

DI void st_bf16x8(u16* p, const f32x4 v0, const f32x4 v1) {
    u32x4 w; w.x = cvt_pk_bf16(v0[0], v0[1]); w.y = cvt_pk_bf16(v0[2], v0[3]); w.z = cvt_pk_bf16(v1[0], v1[1]); w.w = cvt_pk_bf16(v1[2], v1[3]);
    *(u32x4*)p = w;
}

struct EpiMlstmIn {
    u16 *qb, *kb, *vb, *ob; float *li, *lf; const float *big, *bfg;
    DI void operator()(const AccT& acc, const Unit& u, int wr, int wc, int fr, int fq) const {
        const int row0 = u.pm * 256 + wr * 64 + fr, ct = u.pn * 256;
#pragma unroll
        for (int ai = 0; ai < 2; ++ai)
#pragma unroll
            for (int m = 0; m < 4; ++m) {
                const size_t row = (size_t)(row0 + ai * 128 + m * 16);
#pragma unroll
                for (int bj = 0; bj < 2; ++bj) {
                    const int col = ct + bj * 128 + wc * 32 + 8 * fq;
                    f32x4 v0 = acc[ai][bj][m][0], v1 = acc[ai][bj][m][1];
                    if (ct < 1024) st_bf16x8(qb + row * 1024 + col, v0, v1);
                    else if (ct < 2048) st_bf16x8(kb + row * 1024 + (col - 1024), v0 * 0.08838834764831845f, v1 * 0.08838834764831845f);
                    else if (ct < 4096) st_bf16x8(vb + row * 2048 + (col - 2048), v0, v1);
                    else if (ct < 6144) {
#pragma unroll
                        for (int j = 0; j < 4; ++j) { v0[j] = sigm(v0[j]); v1[j] = sigm(v1[j]); }
                        st_bf16x8(ob + row * 2048 + (col - 4096), v0, v1);
                    } else if (col == 6144) {
                        f32x4 a, b;
#pragma unroll
                        for (int j = 0; j < 4; ++j) { a[j] = softcap15(v0[j] + big[j]); b[j] = softcap15(v1[j] + big[4 + j]); }
                        *(f32x4*)(li + row * 8) = a; *(f32x4*)(li + row * 8 + 4) = b;
                    } else if (col == 6152) {
                        f32x4 a, b;
#pragma unroll
                        for (int j = 0; j < 4; ++j) { const float x0 = softcap15(v0[j] + bfg[j]), x1 = softcap15(v1[j] + bfg[4 + j]); a[j] = -softplus(-x0); b[j] = -softplus(-x1); }
                        *(f32x4*)(lf + row * 8) = a; *(f32x4*)(lf + row * 8 + 4) = b;
                    }
                }
            }
    }
};

struct EpiResid {
    u16* h; float* ssq; const float* gamma; u16* An;
    DI void operator()(const AccT& acc, const Unit& u, int wr, int wc, int fr, int fq) const {
        const int row0 = u.rb + wr * 64 + fr, ct = u.pn * 256;
#pragma unroll
        for (int ai = 0; ai < 2; ++ai)
#pragma unroll
            for (int m = 0; m < 4; ++m) {
                if (ai == 1 && u.hm) continue;
                const size_t row = (size_t)(row0 + ai * 128 + m * 16);
                float sq = 0.f;
#pragma unroll
                for (int bj = 0; bj < 2; ++bj) {
                    const int col = ct + bj * 128 + wc * 32 + 8 * fq;
                    u16* hp = h + row * D + col;
                    const u32x4 hw = *(const u32x4*)hp;
                    f32x4 h0 = (f32x4){bflo(hw.x), bfhi(hw.x), bflo(hw.y), bfhi(hw.y)} + acc[ai][bj][m][0], h1 = (f32x4){bflo(hw.z), bfhi(hw.z), bflo(hw.w), bfhi(hw.w)} + acc[ai][bj][m][1];
                    st_bf16x8(hp, h0, h1);
                    sq += h0[0] * h0[0] + h0[1] * h0[1] + h0[2] * h0[2] + h0[3] * h0[3] + h1[0] * h1[0] + h1[1] * h1[1] + h1[2] * h1[2] + h1[3] * h1[3];
                    const f32x4 g0 = *(const f32x4*)(gamma + col), g1 = *(const f32x4*)(gamma + col + 4);
                    st_bf16x8(An + row * D + col, h0 * g0, h1 * g1);
                }
                sq += __shfl_xor(sq, 16); sq += __shfl_xor(sq, 32);
                if (fq == 0) atomicAdd(ssq + row, sq);
            }
    }
};

struct EpiSwiglu {
    const float* ssq; u16* act;
    DI void operator()(const AccT& acc, const Unit& u, int wr, int wc, int fr, int fq) const {
        const int row0 = u.pm * 256 + wr * 64 + fr; const int col = u.pn * 128 + wc * 32 + 8 * fq;
#pragma unroll
        for (int ai = 0; ai < 2; ++ai)
#pragma unroll
            for (int m = 0; m < 4; ++m) {
                const size_t row = (size_t)(row0 + ai * 128 + m * 16);
                const float s = rsqrtf(ssq[row] * (1.0f / D) + NEPS);
                f32x4 o0, o1;
#pragma unroll
                for (int j = 0; j < 4; ++j) {
                    const float g0 = acc[ai][0][m][0][j] * s, u0 = acc[ai][1][m][0][j] * s, g1 = acc[ai][0][m][1][j] * s, u1 = acc[ai][1][m][1][j] * s;
                    o0[j] = g0 * sigm(g0) * u0; o1[j] = g1 * sigm(g1) * u1;
                }
                st_bf16x8(act + row * DFF + col, o0, o1);
            }
    }
};

struct EpiPle {
    const float* ssq_in; const u16* pp; u16* h; float* ssq_out;
    DI void operator()(const AccT& acc, const Unit& u, int wr, int wc, int fr, int fq) const {
        const int row0 = u.rb + wr * 64 + fr, ct = u.pn * 256;
#pragma unroll
        for (int ai = 0; ai < 2; ++ai)
#pragma unroll
            for (int m = 0; m < 4; ++m) {
                if (ai == 1 && u.hm) continue;
                const size_t row = (size_t)(row0 + ai * 128 + m * 16);
                const float s = rsqrtf(ssq_in[row] * (1.0f / D) + NEPS);
                float sq = 0.f;
#pragma unroll
                for (int bj = 0; bj < 2; ++bj) {
                    const int col = ct + bj * 128 + wc * 32 + 8 * fq;
                    u16* hp = h + row * D + col;
                    const u32x4 pw = *(const u32x4*)(pp + row * D + col);
                    const u32x4 hw = *(const u32x4*)hp;
                    f32x4 h0 = (f32x4){bflo(hw.x), bfhi(hw.x), bflo(hw.y), bfhi(hw.y)}, h1 = (f32x4){bflo(hw.z), bfhi(hw.z), bflo(hw.w), bfhi(hw.w)};
                    const f32x4 a0 = acc[ai][bj][m][0], a1 = acc[ai][bj][m][1];
                    h0[0] += sigm(a0[0] * s) * bflo(pw.x); h0[1] += sigm(a0[1] * s) * bfhi(pw.x); h0[2] += sigm(a0[2] * s) * bflo(pw.y); h0[3] += sigm(a0[3] * s) * bfhi(pw.y);
                    h1[0] += sigm(a1[0] * s) * bflo(pw.z); h1[1] += sigm(a1[1] * s) * bfhi(pw.z); h1[2] += sigm(a1[2] * s) * bflo(pw.w); h1[3] += sigm(a1[3] * s) * bfhi(pw.w);
                    st_bf16x8(hp, h0, h1);
                    sq += h0[0] * h0[0] + h0[1] * h0[1] + h0[2] * h0[2] + h0[3] * h0[3] + h1[0] * h1[0] + h1[1] * h1[1] + h1[2] * h1[2] + h1[3] * h1[3];
                }
                if (ssq_out) { sq += __shfl_xor(sq, 16); sq += __shfl_xor(sq, 32); if (fq == 0) atomicAdd(ssq_out + row, sq); }
            }
    }
};

struct EpiRwkvIn {
    u16* rkv; u16* lora;
    DI void operator()(const AccT& acc, const Unit& u, int wr, int wc, int fr, int fq) const {
        const int row0 = u.pm * 256 + wr * 64 + fr, ct = u.pn * 256, g = u.g;
#pragma unroll
        for (int ai = 0; ai < 2; ++ai)
#pragma unroll
            for (int m = 0; m < 4; ++m) {
                const size_t row = (size_t)(row0 + ai * 128 + m * 16);
#pragma unroll
                for (int bj = 0; bj < 2; ++bj) {
                    const int col = ct + bj * 128 + wc * 32 + 8 * fq;
                    f32x4 v0 = acc[ai][bj][m][0], v1 = acc[ai][bj][m][1];
                    if (g < 3) st_bf16x8(rkv + (size_t)g * MT * D + row * D + col, v0, v1);
                    else {
                        if (g == 3) {
#pragma unroll
                            for (int j = 0; j < 4; ++j) { v0[j] = fast_tanh(v0[j]); v1[j] = fast_tanh(v1[j]); }
                        } else if (g == 5) {
#pragma unroll
                            for (int j = 0; j < 4; ++j) { v0[j] = sigm(v0[j]); v1[j] = sigm(v1[j]); }
                        }
                        if (g != 5 && col >= 96) { v0 = (f32x4){0.f, 0.f, 0.f, 0.f}; v1 = v0; }
                        st_bf16x8(lora + (size_t)(g - 3) * MT * 256 + row * 256 + col, v0, v1);
                    }
                }
            }
    }
};

struct EpiLora2 {
    float* wbuf; float* abuf; u16* gbuf; u16* ppb; const float* w0; const float* a0; int gbase;
    DI void operator()(const AccT& acc, const Unit& u, int wr, int wc, int fr, int fq) const {
        const int row0 = u.pm * 256 + wr * 64 + fr, ct = u.pn * 256, g = u.g + gbase;
#pragma unroll
        for (int ai = 0; ai < 2; ++ai)
#pragma unroll
            for (int m = 0; m < 4; ++m) {
                const size_t row = (size_t)(row0 + ai * 128 + m * 16);
#pragma unroll
                for (int bj = 0; bj < 2; ++bj) {
                    const int col = ct + bj * 128 + wc * 32 + 8 * fq;
                    f32x4 v0 = acc[ai][bj][m][0], v1 = acc[ai][bj][m][1];
                    if (g < 2) {
                        const float* bias = g ? a0 : w0; float* dst = g ? abuf : wbuf;
                        const f32x4 b0 = *(const f32x4*)(bias + col), b1 = *(const f32x4*)(bias + col + 4);
                        if (g == 0) { *(f32x4*)(dst + row * D + col) = v0 + b0; *(f32x4*)(dst + row * D + col + 4) = v1 + b1; }
                        else st_bf16x8((u16*)abuf + row * D + col, v0 + b0, v1 + b1);
                    } else if (g == 2) st_bf16x8(gbuf + row * D + col, v0, v1);
                    else st_bf16x8(ppb + row * D + col, v0, v1);
                }
            }
    }
};

struct EpiResidS {
    u16* h; float* ssq; const float* gamma; u16* An;
    DI void operator()(const f32x16& acc, const int row, const int cb, const int half) const {
        float sq = 0.f;
#pragma unroll
        for (int g = 0; g < 4; ++g) {
            const int col = cb + 8 * g; u16* hp = h + (size_t)row * D + col;
            const u32x2 hw = *(const u32x2*)hp;
            const f32x4 hv = (f32x4){bflo(hw.x) + acc[4 * g], bfhi(hw.x) + acc[4 * g + 1], bflo(hw.y) + acc[4 * g + 2], bfhi(hw.y) + acc[4 * g + 3]};
            u32x2 o; o.x = pk2(hv[0], hv[1]); o.y = pk2(hv[2], hv[3]); *(u32x2*)hp = o;
            sq += hv[0] * hv[0] + hv[1] * hv[1] + hv[2] * hv[2] + hv[3] * hv[3];
            const f32x4 g4 = *(const f32x4*)(gamma + col);
            u32x2 a; a.x = pk2(hv[0] * g4[0], hv[1] * g4[1]); a.y = pk2(hv[2] * g4[2], hv[3] * g4[3]); *(u32x2*)(An + (size_t)row * D + col) = a;
        }
        sq += __shfl_xor(sq, 32);
        if (half == 0) atomicAdd(ssq + row, sq);
    }
};
struct EpiPleS {
    const float* ssq_in; const u16* pp; u16* h; float* ssq_out;
    DI void operator()(const f32x16& acc, const int row, const int cb, const int half) const {
        const float s = rsqrtf(ssq_in[row] * (1.0f / D) + NEPS);
        float sq = 0.f;
#pragma unroll
        for (int g = 0; g < 4; ++g) {
            const int col = cb + 8 * g; u16* hp = h + (size_t)row * D + col;
            const u32x2 hw = *(const u32x2*)hp, pw = *(const u32x2*)(pp + (size_t)row * D + col);
            f32x4 hv;
            hv[0] = bflo(hw.x) + sigm(acc[4 * g] * s) * bflo(pw.x); hv[1] = bfhi(hw.x) + sigm(acc[4 * g + 1] * s) * bfhi(pw.x);
            hv[2] = bflo(hw.y) + sigm(acc[4 * g + 2] * s) * bflo(pw.y); hv[3] = bfhi(hw.y) + sigm(acc[4 * g + 3] * s) * bfhi(pw.y);
            u32x2 o; o.x = pk2(hv[0], hv[1]); o.y = pk2(hv[2], hv[3]); *(u32x2*)hp = o;
            sq += hv[0] * hv[0] + hv[1] * hv[1] + hv[2] * hv[2] + hv[3] * hv[3];
        }
        if (ssq_out) { sq += __shfl_xor(sq, 32); if (half == 0) atomicAdd(ssq_out + row, sq); }
    }
};
template <class Epi>
DI void sgemm_sample(LAS unsigned char* lds, const u16* __restrict__ A, const u16* __restrict__ Bt, const int K, const Epi& E, const int wv) {
    const int tid = opaque_tid(wv), wid = tid >> 6, lane = tid & 63, l32 = lane & 31, half = lane >> 5, wm = wid >> 1, wn = wid & 1;
    LAS u16* As = (LAS u16*)lds;
    LAS u16* Bs = (LAS u16*)(lds + 69632);
    const int nk = K / 128;
    const int ar = tid >> 4, kc = (tid & 15) * 8;
    for (int tile = blockIdx.x; tile < 256; tile += gridDim.x) {
        const int row0 = (tile >> 5) * 128, col0 = (tile & 31) * 64;
        f32x16 acc;
#pragma unroll
        for (int j = 0; j < 16; ++j) acc[j] = 0.f;
        const u16* ap = A + (size_t)(row0 + ar) * K + kc; const u16* bp = Bt + (size_t)(col0 + ar) * K + kc;
        const size_t r32 = (size_t)32 * K;
#define SG_LOAD(x, step) do { x##0 = *(const u32x4*)(ap + (step) * 128); x##1 = *(const u32x4*)(ap + r32 + (step) * 128); x##2 = *(const u32x4*)(ap + 2 * r32 + (step) * 128); x##3 = *(const u32x4*)(ap + 3 * r32 + (step) * 128); \
        x##4 = *(const u32x4*)(bp + (step) * 128); x##5 = *(const u32x4*)(bp + r32 + (step) * 128); } while (0)
#define SG_STORE(x, buf) do { LAS u16* a_ = As + (buf) * (128 * 136) + ar * 136 + kc; LAS u16* b_ = Bs + (buf) * (64 * 136) + ar * 136 + kc; \
        *(LAS u32x4*)(a_) = x##0; *(LAS u32x4*)(a_ + 32 * 136) = x##1; *(LAS u32x4*)(a_ + 64 * 136) = x##2; *(LAS u32x4*)(a_ + 96 * 136) = x##3; *(LAS u32x4*)(b_) = x##4; *(LAS u32x4*)(b_ + 32 * 136) = x##5; } while (0)
#define SG_COMPUTE(buf) do { const LAS u16* as = As + (buf) * (128 * 136) + (wm * 32 + l32) * 136 + 8 * half; const LAS u16* bs = Bs + (buf) * (64 * 136) + (wn * 32 + l32) * 136 + 8 * half; \
        _Pragma("unroll") for (int ks = 0; ks < 8; ++ks) { const bf16x8 af = *(const LAS bf16x8*)(as + 16 * ks), bf = *(const LAS bf16x8*)(bs + 16 * ks); acc = __builtin_amdgcn_mfma_f32_32x32x16_bf16(bf, af, acc, 0, 0, 0); } } while (0)
        u32x4 p0, p1, p2, p3, p4, p5, q0, q1, q2, q3, q4, q5;
        SG_LOAD(p, 0); SG_STORE(p, 0); SG_LOAD(p, 1); SG_LOAD(q, 2);
        __syncthreads();
        for (int kt = 0; kt < nk; kt += 2) {
            SG_COMPUTE(0); SG_STORE(p, 1); if (kt + 3 < nk) SG_LOAD(p, kt + 3);
            __syncthreads();
            SG_COMPUTE(1); if (kt + 2 < nk) SG_STORE(q, 0); if (kt + 4 < nk) SG_LOAD(q, kt + 4);
            __syncthreads();
        }
#undef SG_LOAD
#undef SG_STORE
#undef SG_COMPUTE
        E(acc, MPR + row0 + wm * 32 + l32, col0 + wn * 32 + 4 * half, half);
    }
}

DI void sgemm_swiglu_tile(LAS unsigned char* lds, const u16* __restrict__ A, const u16* __restrict__ Wgu, const float* __restrict__ ssq, u16* __restrict__ act, const int wv, const int row0, const int c0) {
    const int tid = opaque_tid(wv), wid = tid >> 6, lane = tid & 63, l32 = lane & 31, half = lane >> 5, wm = wid >> 1, wn = wid & 1;
    LAS u16* As = (LAS u16*)lds;
    LAS u16* Bs = (LAS u16*)(lds + 36864);
    const int K = D, nk = K / 64;
    const int ar = tid >> 3, kc = (tid & 7) * 8;
    {
        const int brow = (c0 >> 7) * 256 + (c0 & 127);
        f32x16 ag, au;
#pragma unroll
        for (int j = 0; j < 16; ++j) { ag[j] = 0.f; au[j] = 0.f; }
        const u16* ap0 = A + (size_t)(row0 + ar) * K + kc; const u16* ap1 = ap0 + (size_t)64 * K;
        const u16* bp0 = Wgu + (size_t)(brow + ar) * K + kc; const u16* bp1 = bp0 + (size_t)128 * K;
#define SW_LOAD(x, step) do { x##0 = *(const u32x4*)(ap0 + (step) * 64); x##1 = *(const u32x4*)(ap1 + (step) * 64); x##2 = *(const u32x4*)(bp0 + (step) * 64); x##3 = *(const u32x4*)(bp1 + (step) * 64); } while (0)
#define SW_STORE(x, buf) do { *(LAS u32x4*)(As + (buf) * (128 * 72) + ar * 72 + kc) = x##0; *(LAS u32x4*)(As + (buf) * (128 * 72) + (ar + 64) * 72 + kc) = x##1; \
        *(LAS u32x4*)(Bs + (buf) * (128 * 72) + ar * 72 + kc) = x##2; *(LAS u32x4*)(Bs + (buf) * (128 * 72) + (ar + 64) * 72 + kc) = x##3; } while (0)
#define SW_COMPUTE(buf) do { const LAS u16* as = As + (buf) * (128 * 72) + (wm * 32 + l32) * 72 + 8 * half; const LAS u16* bs = Bs + (buf) * (128 * 72) + (wn * 32 + l32) * 72 + 8 * half; \
        _Pragma("unroll") for (int ks = 0; ks < 4; ++ks) { const bf16x8 af = *(const LAS bf16x8*)(as + 16 * ks), bg = *(const LAS bf16x8*)(bs + 16 * ks), bu = *(const LAS bf16x8*)(bs + 64 * 72 + 16 * ks); \
            ag = __builtin_amdgcn_mfma_f32_32x32x16_bf16(bg, af, ag, 0, 0, 0); au = __builtin_amdgcn_mfma_f32_32x32x16_bf16(bu, af, au, 0, 0, 0); } } while (0)
        u32x4 p0, p1, p2, p3, q0, q1, q2, q3;
        SW_LOAD(p, 0); SW_STORE(p, 0); SW_LOAD(p, 1); SW_LOAD(q, 2);
        __syncthreads();
        for (int kt = 0; kt < nk; kt += 2) {
            SW_COMPUTE(0); SW_STORE(p, 1); if (kt + 3 < nk) SW_LOAD(p, kt + 3);
            __syncthreads();
            SW_COMPUTE(1); if (kt + 2 < nk) SW_STORE(q, 0); if (kt + 4 < nk) SW_LOAD(q, kt + 4);
            __syncthreads();
        }
#undef SW_LOAD
#undef SW_STORE
#undef SW_COMPUTE
        const int row = row0 + wm * 32 + l32, cb = c0 + wn * 32 + 4 * half;
        const float sc = rsqrtf(ssq[row] * (1.0f / D) + NEPS);
#pragma unroll
        for (int g = 0; g < 4; ++g) {
            float o[4];
#pragma unroll
            for (int i = 0; i < 4; ++i) { const float gg = ag[4 * g + i] * sc, uu = au[4 * g + i] * sc; o[i] = gg * sigm(gg) * uu; }
            u32x2 w; w.x = pk2(o[0], o[1]); w.y = pk2(o[2], o[3]);
            *(u32x2*)(act + (size_t)row * DFF + cb + 8 * g) = w;
        }
    }
}

DI void cvt_weight(const float* __restrict__ src, int K, int N, u16* __restrict__ dst, int Kpad, int Nw, int row_off, int il, int& tbase, LAS u16* T, const int wv, const int rank, const int G) {
    const int tid = opaque_tid(wv);
    const int nkt = Kpad / 64, nnt = (Nw + 63) / 64, ntile = nkt * nnt;
    int first = rank - (tbase % G); if (first < 0) first += G;
    const int klb = tid >> 4, nl4 = (tid & 15) * 4;
    f32x4 cv0 = (f32x4){0.f, 0.f, 0.f, 0.f}, cv1 = cv0;
    if (first < ntile) {
        const int n0 = (first % nnt) * 64, k0 = (first / nnt) * 64;
        if (k0 + klb < K && n0 + nl4 < N) cv0 = __builtin_nontemporal_load((const f32x4*)(src + (size_t)(k0 + klb) * N + n0 + nl4));
        if (k0 + klb + 32 < K && n0 + nl4 < N) cv1 = __builtin_nontemporal_load((const f32x4*)(src + (size_t)(k0 + klb + 32) * N + n0 + nl4));
    }
    for (int tile = first; tile < ntile; tile += G) {
        const int n0 = (tile % nnt) * 64, k0 = (tile / nnt) * 64;
        f32x4 nv0 = (f32x4){0.f, 0.f, 0.f, 0.f}, nv1 = nv0;
        if (tile + G < ntile) {
            const int t2 = tile + G, m0 = (t2 % nnt) * 64, j0 = (t2 / nnt) * 64;
            if (j0 + klb < K && m0 + nl4 < N) nv0 = __builtin_nontemporal_load((const f32x4*)(src + (size_t)(j0 + klb) * N + m0 + nl4));
            if (j0 + klb + 32 < K && m0 + nl4 < N) nv1 = __builtin_nontemporal_load((const f32x4*)(src + (size_t)(j0 + klb + 32) * N + m0 + nl4));
        }
#pragma unroll
        for (int j = 0; j < 4; ++j) { T[(nl4 + j) * 72 + klb] = (u16)f2bf(cv0[j]); T[(nl4 + j) * 72 + klb + 32] = (u16)f2bf(cv1[j]); }
        __syncthreads();
        {
            const int nl = tid >> 3, kk = (tid & 7) * 8, n = n0 + nl;
            if (n < Nw) {
                const int drow = il ? (((n >> 7) << 8) + row_off + (n & 127)) : (row_off + n);
                *(u32x4*)(dst + (size_t)drow * Kpad + k0 + kk) = *(const LAS u32x4*)(T + nl * 72 + kk);
            }
        }
        __syncthreads();
        cv0 = nv0; cv1 = nv1;
    }
    tbase += ntile;
}

__device__ __forceinline__ void convert_group(PP p, LAS unsigned char* lds, const int wv, const int grp, const int rank, const int nblk) {
    unsigned char* ws = p->ws; LAS u16* T = (LAS u16*)lds; int tb = 0;
    const size_t DD = (size_t)D * D;
    if (grp == 0) {
        u16* win0 = (u16*)(ws + OFF_W_IN0);
        cvt_weight(p->in[I_MQ], D, 1024, win0, D, 1024, 0, 0, tb, T, wv, rank, nblk);
        cvt_weight(p->in[I_MK], D, 1024, win0, D, 1024, 1024, 0, tb, T, wv, rank, nblk);
        cvt_weight(p->in[I_MV], D, 2048, win0, D, 2048, 2048, 0, tb, T, wv, rank, nblk);
        cvt_weight(p->in[I_MOG], D, 2048, win0, D, 2048, 4096, 0, tb, T, wv, rank, nblk);
        cvt_weight(p->in[I_MIG], D, 8, win0, D, 8, 6144, 0, tb, T, wv, rank, nblk);
        cvt_weight(p->in[I_MFG], D, 8, win0, D, 248, 6152, 0, tb, T, wv, rank, nblk);
        cvt_weight(p->in[I_PWP], 256, D, (u16*)(ws + OFF_W_PP), 256, D, 0, 0, tb, T, wv, rank, nblk);
    } else {
        const int l = grp - 1;
        if (l == 0) cvt_weight(p->in[I_MOUT], D, 2048, (u16*)(ws + OFF_W_OUT0), D, 2048, 0, 0, tb, T, wv, rank, nblk);
        else cvt_weight(p->in[I_RWO], D, D, (u16*)(ws + OFF_W_OUT1), D, D, 0, 0, tb, T, wv, rank, nblk);
        cvt_weight(p->in[I_FG] + (size_t)l * D * DFF, D, DFF, (u16*)(ws + OFF_W_GU + l * SZ_W_GU), D, DFF, 0, 1, tb, T, wv, rank, nblk);
        cvt_weight(p->in[I_FU] + (size_t)l * D * DFF, D, DFF, (u16*)(ws + OFF_W_GU + l * SZ_W_GU), D, DFF, 128, 1, tb, T, wv, rank, nblk);
        cvt_weight(p->in[I_FD] + (size_t)l * D * DFF, DFF, D, (u16*)(ws + OFF_W_DN + l * SZ_W_DN), DFF, D, 0, 0, tb, T, wv, rank, nblk);
        cvt_weight(p->in[I_PWG] + l * DD, D, D, (u16*)(ws + OFF_W_PG + l * SZ_SQ), D, D, 0, 0, tb, T, wv, rank, nblk);
        if (l == 0) {
            cvt_weight(p->in[I_PWP] + (size_t)256 * D, 256, D, (u16*)(ws + OFF_W_PP + SZ_W_PP), 256, D, 0, 0, tb, T, wv, rank, nblk);
            u16* win1 = (u16*)(ws + OFF_W_IN1);
            cvt_weight(p->in[I_RWR], D, D, win1, D, D, 0, 0, tb, T, wv, rank, nblk);
            cvt_weight(p->in[I_RWK], D, D, win1, D, D, 2048, 0, tb, T, wv, rank, nblk);
            cvt_weight(p->in[I_RWV], D, D, win1, D, D, 4096, 0, tb, T, wv, rank, nblk);
            cvt_weight(p->in[I_RW1], D, 96, win1, D, 256, 6144, 0, tb, T, wv, rank, nblk);
            cvt_weight(p->in[I_RA1], D, 96, win1, D, 256, 6400, 0, tb, T, wv, rank, nblk);
            cvt_weight(p->in[I_RG1], D, 256, win1, D, 256, 6656, 0, tb, T, wv, rank, nblk);
            cvt_weight(p->in[I_RW2], 96, D, (u16*)(ws + OFF_W_L2), 256, D, 0, 0, tb, T, wv, rank, nblk);
            cvt_weight(p->in[I_RA2], 96, D, (u16*)(ws + OFF_W_L2 + SZ_W_PP), 256, D, 0, 0, tb, T, wv, rank, nblk);
            cvt_weight(p->in[I_RG2], 256, D, (u16*)(ws + OFF_W_L2 + 2 * SZ_W_PP), 256, D, 0, 0, tb, T, wv, rank, nblk);
        }
    }
}
__device__ __forceinline__ void phase0(PP p, LAS unsigned char* lds, const int wv) {
    unsigned char* ws = p->ws;
    convert_group(p, lds, wv, 0, (int)blockIdx.x, (int)gridDim.x);
    const int tid = opaque_tid(wv), wid = tid >> 6, lane = tid & 63;
    {
        u16* h = (u16*)(ws + OFF_H); u16* an = (u16*)(ws + OFF_BIG);
        const float* gam = p->in[I_NMIX];
        for (int row = blockIdx.x * 8 + wid; row < MT; row += gridDim.x * 8) {
            const float* xr = row < MPR ? p->in[I_XP] + (size_t)row * D : p->in[I_XS] + (size_t)(row - MPR) * D;
            f32x4 v[8]; float ss = 0.f;
#pragma unroll
            for (int i = 0; i < 8; ++i) { v[i] = __builtin_nontemporal_load((const f32x4*)(xr + 4 * (lane + 64 * i))); ss += v[i][0] * v[i][0] + v[i][1] * v[i][1] + v[i][2] * v[i][2] + v[i][3] * v[i][3]; }
            ss = wave_sum(ss);
            const float rs = rsqrtf(ss * (1.0f / D) + NEPS);
#pragma unroll
            for (int i = 0; i < 8; ++i) {
                const int c = 4 * (lane + 64 * i);
                { u32x2 hw; hw.x = pk2(v[i][0], v[i][1]); hw.y = pk2(v[i][2], v[i][3]); *(u32x2*)(h + (size_t)row * D + c) = hw; }
                const f32x4 g = *(const f32x4*)(gam + c);
                u32x2 w; w.x = pk2(v[i][0] * rs * g[0], v[i][1] * rs * g[1]); w.y = pk2(v[i][2] * rs * g[2], v[i][3] * rs * g[3]);
                *(u32x2*)(an + (size_t)row * D + c) = w;
            }
        }
    }
    {
        u16* ap = (u16*)(ws + OFF_AP);
        const int nitem = 2 * MT * 64;
        for (int it = blockIdx.x * 512 + tid; it < nitem; it += gridDim.x * 512) {
            const int c = (it & 63) * 4, rl = it >> 6, l = rl / MT, row = rl - l * MT;
            const float* src = row < MPR ? p->in[I_PP] + ((size_t)l * MPR + row) * 256 + c : p->in[I_PS] + ((size_t)l * 1024 + (row - MPR)) * 256 + c;
            const f32x4 v = __builtin_nontemporal_load((const f32x4*)src);
            u32x2 w; w.x = pk2(v[0], v[1]); w.y = pk2(v[2], v[3]);
            *(u32x2*)(ap + (size_t)rl * 256 + c) = w;
        }
    }
    { float* ssq = (float*)(ws + OFF_SSQ); for (int i = blockIdx.x * 512 + tid; i < 5 * MT; i += gridDim.x * 512) ssq[i] = 0.f; }
}

#define MLSTM_LOADS(ROW0) do { const int row0_ = (ROW0); int tid_ = tid; asm volatile("" : "+v"(tid_)); \
    _Pragma("unroll") for (int i = 0; i < 2; ++i) { const int idx = tid_ + 512 * i, t = idx >> 4, d8 = (idx & 15) * 8; \
        pq[i] = (u32x4){0u, 0u, 0u, 0u}; pk[i] = pq[i]; \
        if (t < valid) { pq[i] = *(const u32x4*)(qb + (size_t)(row0_ + t) * 1024 + hd * 128 + d8); pk[i] = *(const u32x4*)(kb + (size_t)(row0_ + t) * 1024 + hd * 128 + d8); } } \
    _Pragma("unroll") for (int i = 0; i < 2; ++i) { const int it = tid_ + 512 * i, tp = it & 31, e8 = (it >> 5) * 8, t0 = 2 * tp; \
        pv0[i] = (u32x4){0u, 0u, 0u, 0u}; pv1[i] = pv0[i]; \
        if (t0 < valid) pv0[i] = *(const u32x4*)(vb + (size_t)(row0_ + t0) * 2048 + hd * 256 + e8); \
        if (t0 + 1 < valid) pv1[i] = *(const u32x4*)(vb + (size_t)(row0_ + t0 + 1) * 2048 + hd * 256 + e8); } } while (0)
__device__ __forceinline__ void mlstm_scan(PP p, LAS unsigned char* lds, const int wv) {
    const int tid = opaque_tid(wv), wid = tid >> 6, lane = tid & 63, l32 = lane & 31, half = lane >> 5;
    LAS u16* Qs = (LAS u16*)(lds + 0);
    LAS u16* Ks = (LAS u16*)(lds + 17408);
    LAS u16* KwT = (LAS u16*)(lds + 34816);
    LAS u16* VT = (LAS u16*)(lds + 53248);
    LAS u16* Sp = (LAS u16*)(lds + 90112);
    LAS u16* Hs = (LAS u16*)(lds + 99328);
    LAS float* sg = (LAS float*)(lds + 133120);
    LAS float* sM = sg + 64; LAS float* swk = sg + 128; LAS float* swi = sg + 192; LAS float* sen = sg + 256; LAS float* sinv = sg + 320;
    LAS float* n_s = sg + 384; LAS float* sc = sg + 512; LAS float* nw_s = sg + 576;
    unsigned char* ws = p->ws;
    const u16* qb = (const u16*)(ws + OFF_BIG + SZ_ACT); const u16* kb = (const u16*)(ws + OFF_BIG + SZ_ACT + SZ_ACT / 2);
    const u16* vb = (const u16*)(ws + OFF_BIG + 2 * SZ_ACT); const u16* ob = (const u16*)(ws + OFF_BIG + 3 * SZ_ACT);
    u16* aout = (u16*)(ws + OFF_BIG + 5 * SZ_ACT);
    const float* lig = (const float*)(ws + OFF_LG); const float* lfg = lig + (size_t)MT * 8;
    const float* normw = p->in[I_MNW];

    const int G = gridDim.x, bid = blockIdx.x;
    int u0, ust;
    if (G > 64) { if (bid < 32) { u0 = bid; ust = 1 << 20; } else { u0 = 32 + (bid - 32); ust = G - 32; } } else { u0 = bid; ust = G; }
    for (int u = u0; u < 1056; u += ust) {
        const bool pr = u < 32; int b, hd, row_base, nchunk, valid;
        if (pr) { b = u >> 3; hd = u & 7; row_base = b * 2048; nchunk = 32; valid = 64; }
        else { const int s = u - 32; b = s >> 3; hd = s & 7; row_base = MPR + b * 8; nchunk = 1; valid = 8; }
        const int bh = b * 8 + hd;
        f32x16 Cacc[4];
        if (pr) {
#pragma unroll
            for (int dt = 0; dt < 4; ++dt)
#pragma unroll
                for (int j = 0; j < 16; ++j) Cacc[dt][j] = 0.f;
        } else {
            int lq = lane; asm volatile("" : "+v"(lq));
            const float* C0 = p->in[I_MC] + (size_t)bh * 32768 + ((lq >> 5) * 4) * 256 + 32 * wid + (lq & 31);
#pragma unroll
            for (int dt = 0; dt < 4; ++dt)
#pragma unroll
                for (int j = 0; j < 16; ++j) Cacc[dt][j] = __builtin_nontemporal_load(C0 + (32 * dt + crow(j, 0)) * 256);
        }
        if (tid < 128) n_s[tid] = pr ? 0.f : p->in[I_MN][bh * 128 + tid];
        if (tid == 0) sc[0] = pr ? 0.f : p->in[I_MM][bh];
        if (tid < 256) nw_s[tid] = normw[hd * 256 + tid];
        u32x4 pq[2], pk[2], pv0[2], pv1[2];
        MLSTM_LOADS(row_base);
        float nli = -1e30f, nlf = 0.f;
        if (wid == 0 && lane < valid) { nli = lig[(size_t)(row_base + lane) * 8 + hd]; nlf = lfg[(size_t)(row_base + lane) * 8 + hd]; }
        __syncthreads();
        for (int c = 0; c < nchunk; ++c) {
            const int row0 = row_base + 64 * c;
            int tidc = tid; asm volatile("" : "+v"(tidc));
            const int lanec = tidc & 63, l32c = lanec & 31, halfc = lanec >> 5;
            if (wid == 0) {
                const int t = lanec; const float m = sc[0];
                const float li_t = nli, lf_t = nlf;
                if (c + 1 < nchunk) { nli = lig[(size_t)(row0 + 64 + t) * 8 + hd]; nlf = lfg[(size_t)(row0 + 64 + t) * 8 + hd]; }
                float bsum = lf_t;
#pragma unroll
                for (int o = 1; o < 64; o <<= 1) { const float x = __shfl_up(bsum, o); if (lanec >= o) bsum += x; }
                const float gs = li_t - bsum;
                float pm = gs;
#pragma unroll
                for (int o = 1; o < 64; o <<= 1) { const float x = __shfl_up(pm, o); if (lanec >= o) pm = fmaxf(pm, x); }
                const float M = fmaxf(m, pm);
                const float M63 = __shfl(M, 63), b63 = __shfl(bsum, 63);
                sg[t] = gs; sM[t] = M; swk[t] = __expf(gs - M63); swi[t] = __expf(m - M); sen[t] = __expf(-(bsum + M));
                if (lanec == 0) { sc[1] = __expf(m - M63); sc[2] = b63 + M63; }
            }
            __syncthreads();
#pragma unroll
            for (int i = 0; i < 2; ++i) {
                const int idx = tidc + 512 * i, t = idx >> 4, d8 = (idx & 15) * 8;
                *(LAS u32x4*)(Qs + t * 136 + d8) = pq[i]; *(LAS u32x4*)(Ks + t * 136 + d8) = pk[i];
            }
#pragma unroll
            for (int i = 0; i < 2; ++i) {
                const int it = tidc + 512 * i, tp = it & 31, e8 = (it >> 5) * 8, t0 = 2 * tp;
#pragma unroll
                for (int j = 0; j < 4; ++j) {
                    *(LAS unsigned*)(VT + (e8 + 2 * j) * 72 + t0) = (pv0[i][j] & 0xFFFFu) | (pv1[i][j] << 16);
                    *(LAS unsigned*)(VT + (e8 + 2 * j + 1) * 72 + t0) = (pv0[i][j] >> 16) | (pv1[i][j] & 0xFFFF0000u);
                }
            }
            __syncthreads();
            {
                const int tp = tidc & 31, d8 = (tidc >> 5) * 8, t0 = 2 * tp;
                const u32x4 k0 = *(const LAS u32x4*)(Ks + t0 * 136 + d8), k1 = *(const LAS u32x4*)(Ks + (t0 + 1) * 136 + d8);
                const float w0 = swk[t0], w1 = swk[t0 + 1];
#pragma unroll
                for (int j = 0; j < 4; ++j) {
                    *(LAS unsigned*)(KwT + (d8 + 2 * j) * 72 + t0) = pk2(bflo(k0[j]) * w0, bflo(k1[j]) * w1);
                    *(LAS unsigned*)(KwT + (d8 + 2 * j + 1) * 72 + t0) = pk2(bfhi(k0[j]) * w0, bfhi(k1[j]) * w1);
                }
            }
            if (wid < 4) {
                const int ti = wid >> 1, si = wid & 1;
                if (si <= ti) {
                    f32x16 a;
#pragma unroll
                    for (int j = 0; j < 16; ++j) a[j] = 0.f;
#pragma unroll
                    for (int kk = 0; kk < 8; ++kk) {
                        const bf16x8 af = *(const LAS bf16x8*)(Qs + (32 * ti + l32c) * 136 + 16 * kk + 8 * halfc);
                        const bf16x8 bf = *(const LAS bf16x8*)(Ks + (32 * si + l32c) * 136 + 16 * kk + 8 * halfc);
                        a = __builtin_amdgcn_mfma_f32_32x32x16_bf16(af, bf, a, 0, 0, 0);
                    }
                    const int s = 32 * si + l32c; const float gss = sg[s];
#pragma unroll
                    for (int j = 0; j < 16; ++j) {
                        const int t = 32 * ti + crow(j, halfc);
                        const float val = (s <= t) ? a[j] * __expf(gss - sM[t]) : 0.f;
                        Sp[t * 72 + s] = (u16)f2bf(val);
                    }
                } else {
#pragma unroll
                    for (int j = 0; j < 16; ++j) Sp[crow(j, halfc) * 72 + 32 + l32c] = 0;
                }
            }
            __syncthreads();
            {
                const int t = tidc >> 3, part = tidc & 7;
                const u32x4 sv = *(const LAS u32x4*)(Sp + t * 72 + 8 * part);
                float a = bflo(sv.x) + bfhi(sv.x) + bflo(sv.y) + bfhi(sv.y) + bflo(sv.z) + bfhi(sv.z) + bflo(sv.w) + bfhi(sv.w);
                const u32x4 q0 = *(const LAS u32x4*)(Qs + t * 136 + 16 * part), q1 = *(const LAS u32x4*)(Qs + t * 136 + 16 * part + 8);
                float qn = 0.f;
#pragma unroll
                for (int j = 0; j < 4; ++j) {
                    qn += bflo(q0[j]) * n_s[16 * part + 2 * j] + bfhi(q0[j]) * n_s[16 * part + 2 * j + 1];
                    qn += bflo(q1[j]) * n_s[16 * part + 8 + 2 * j] + bfhi(q1[j]) * n_s[16 * part + 8 + 2 * j + 1];
                }
                float tot = a + swi[t] * qn;
                tot = grp8_sum(tot);
                if (part == 0) sinv[t] = 1.0f / fmaxf(fabsf(tot), sen[t]);
            }
            f32x16 N0, N1;
#pragma unroll
            for (int j = 0; j < 16; ++j) { N0[j] = 0.f; N1[j] = 0.f; }
#pragma unroll
            for (int dt = 0; dt < 4; ++dt)
#pragma unroll
                for (int kb2 = 0; kb2 < 2; ++kb2) {
                    u32x4 bw;
                    bw.x = pk2(Cacc[dt][8 * kb2 + 0], Cacc[dt][8 * kb2 + 1]); bw.y = pk2(Cacc[dt][8 * kb2 + 2], Cacc[dt][8 * kb2 + 3]);
                    bw.z = pk2(Cacc[dt][8 * kb2 + 4], Cacc[dt][8 * kb2 + 5]); bw.w = pk2(Cacc[dt][8 * kb2 + 6], Cacc[dt][8 * kb2 + 7]);
                    const bf16x8 bfr = __builtin_bit_cast(bf16x8, bw);
#pragma unroll
                    for (int tt = 0; tt < 2; ++tt) {
                        const LAS u16* qp = Qs + (32 * tt + l32c) * 136 + 32 * dt + 16 * kb2 + 4 * halfc;
                        const u32x2 lo = *(const LAS u32x2*)qp, hi = *(const LAS u32x2*)(qp + 8);
                        u32x4 aw; aw.x = lo.x; aw.y = lo.y; aw.z = hi.x; aw.w = hi.y;
                        const bf16x8 afr = __builtin_bit_cast(bf16x8, aw);
                        if (tt == 0) N0 = __builtin_amdgcn_mfma_f32_32x32x16_bf16(afr, bfr, N0, 0, 0, 0);
                        else N1 = __builtin_amdgcn_mfma_f32_32x32x16_bf16(afr, bfr, N1, 0, 0, 0);
                    }
                    __builtin_amdgcn_sched_barrier(0);
                }
#pragma unroll
            for (int j = 0; j < 16; ++j) { N0[j] *= swi[crow(j, halfc)]; N1[j] *= swi[32 + crow(j, halfc)]; }
            bf16x8 vf[4];
#pragma unroll
            for (int k4 = 0; k4 < 4; ++k4) vf[k4] = *(const LAS bf16x8*)(VT + (32 * wid + l32c) * 72 + 16 * k4 + 8 * halfc);
#pragma unroll
            for (int k4 = 0; k4 < 4; ++k4) {
                if (k4 < 2) { const bf16x8 af = *(const LAS bf16x8*)(Sp + l32c * 72 + 16 * k4 + 8 * halfc); N0 = __builtin_amdgcn_mfma_f32_32x32x16_bf16(af, vf[k4], N0, 0, 0, 0); }
                const bf16x8 af1 = *(const LAS bf16x8*)(Sp + (32 + l32c) * 72 + 16 * k4 + 8 * halfc); N1 = __builtin_amdgcn_mfma_f32_32x32x16_bf16(af1, vf[k4], N1, 0, 0, 0);
            }
            const float decay = sc[1];
#pragma unroll
            for (int dt = 0; dt < 4; ++dt) {
#pragma unroll
                for (int j = 0; j < 16; ++j) Cacc[dt][j] *= decay;
#pragma unroll
                for (int k4 = 0; k4 < 4; ++k4) {
                    const bf16x8 af = *(const LAS bf16x8*)(KwT + (32 * dt + l32c) * 72 + 16 * k4 + 8 * halfc);
                    Cacc[dt] = __builtin_amdgcn_mfma_f32_32x32x16_bf16(af, vf[k4], Cacc[dt], 0, 0, 0);
                }
                __builtin_amdgcn_sched_barrier(0);
            }
            __builtin_amdgcn_sched_barrier(0);
            if (c + 1 < nchunk) MLSTM_LOADS(row0 + 64);
            __syncthreads();
#pragma unroll
            for (int j = 0; j < 16; ++j) {
                const int t0 = crow(j, halfc), t1 = 32 + t0;
                Hs[t0 * 264 + 32 * wid + l32c] = (u16)f2bf(N0[j] * sinv[t0]);
                Hs[t1 * 264 + 32 * wid + l32c] = (u16)f2bf(N1[j] * sinv[t1]);
            }
            __syncthreads();
            {
                const int t = tidc >> 3, part = tidc & 7;
                u32x4 hv[4]; float ss = 0.f;
#pragma unroll
                for (int c4 = 0; c4 < 4; ++c4) {
                    hv[c4] = *(const LAS u32x4*)(Hs + t * 264 + 32 * part + 8 * c4);
#pragma unroll
                    for (int j = 0; j < 4; ++j) { const float a = bflo(hv[c4][j]), bq = bfhi(hv[c4][j]); ss += a * a + bq * bq; }
                }
                ss = grp8_sum(ss);
                const float rs = rsqrtf(ss * (1.0f / 256.0f) + NEPS);
                if (t < valid) {
                    const size_t gofs = (size_t)(row0 + t) * 2048 + hd * 256 + 32 * part;
#pragma unroll
                    for (int c4 = 0; c4 < 4; ++c4) {
                        const u32x4 o8 = *(const u32x4*)(ob + gofs + 8 * c4);
                        const f32x4 w0 = *(const LAS f32x4*)(nw_s + 32 * part + 8 * c4), w1 = *(const LAS f32x4*)(nw_s + 32 * part + 8 * c4 + 4);
                        u32x4 r;
                        r.x = pk2(bflo(hv[c4].x) * rs * w0[0] * bflo(o8.x), bfhi(hv[c4].x) * rs * w0[1] * bfhi(o8.x));
                        r.y = pk2(bflo(hv[c4].y) * rs * w0[2] * bflo(o8.y), bfhi(hv[c4].y) * rs * w0[3] * bfhi(o8.y));
                        r.z = pk2(bflo(hv[c4].z) * rs * w1[0] * bflo(o8.z), bfhi(hv[c4].z) * rs * w1[1] * bfhi(o8.z));
                        r.w = pk2(bflo(hv[c4].w) * rs * w1[2] * bflo(o8.w), bfhi(hv[c4].w) * rs * w1[3] * bfhi(o8.w));
                        *(u32x4*)(aout + gofs + 8 * c4) = r;
                    }
                }
            }
            if (tidc < 128) {
                float s = 0.f;
#pragma unroll
                for (int i = 0; i < 8; ++i) {
                    const u32x4 kv = *(const LAS u32x4*)(KwT + tidc * 72 + 8 * i);
                    s += bflo(kv.x) + bfhi(kv.x) + bflo(kv.y) + bfhi(kv.y) + bflo(kv.z) + bfhi(kv.z) + bflo(kv.w) + bfhi(kv.w);
                }
                n_s[tidc] = decay * n_s[tidc] + s;
            }
            if (tidc == 0) sc[0] = sc[2];
            __syncthreads();
        }
        int lq2 = lane; asm volatile("" : "+v"(lq2));
        float* Co = p->out + (pr ? O_CP : O_CS) + (size_t)bh * 32768 + ((lq2 >> 5) * 4) * 256 + 32 * wid + (lq2 & 31);
#pragma unroll
        for (int dt = 0; dt < 4; ++dt)
#pragma unroll
            for (int j = 0; j < 16; ++j) __builtin_nontemporal_store(Cacc[dt][j], Co + (32 * dt + crow(j, 0)) * 256);
        if (tid < 128) p->out[(pr ? O_NP : O_NS) + (size_t)bh * 128 + tid] = n_s[tid];
        if (tid == 0) p->out[(pr ? O_MP : O_MS) + bh] = sc[0];
        __syncthreads();
    }
}

__device__ __forceinline__ void rwkv_norm_mix(PP p, const int wv) {
    const int tid = opaque_tid(wv), wid = tid >> 6, lane = tid & 63;
    unsigned char* ws = p->ws;
    const u16* h = (const u16*)(ws + OFF_H); u16* a6 = (u16*)(ws + OFF_BIG);
    const float* gam = p->in[I_NMIX] + D; const float* mu = p->in[I_RMU];
    for (int row = blockIdx.x * 8 + wid; row < MT; row += gridDim.x * 8) {
        int b, t, T;
        if (row < MPR) { b = row >> 11; t = row & 2047; T = 2048; } else { b = (row - MPR) >> 3; t = (row - MPR) & 7; T = 8; }
        const u16* hr = h + (size_t)row * D;
        f32x4 v[8], pv[8]; float ss = 0.f, ps = 0.f;
#pragma unroll
        for (int i = 0; i < 8; ++i) { v[i] = ld_bf16x4(hr + 4 * (lane + 64 * i)); ss += v[i][0] * v[i][0] + v[i][1] * v[i][1] + v[i][2] * v[i][2] + v[i][3] * v[i][3]; }
        if (t > 0) {
#pragma unroll
            for (int i = 0; i < 8; ++i) { pv[i] = ld_bf16x4(hr - D + 4 * (lane + 64 * i)); ps += pv[i][0] * pv[i][0] + pv[i][1] * pv[i][1] + pv[i][2] * pv[i][2] + pv[i][3] * pv[i][3]; }
        } else {
#pragma unroll
            for (int i = 0; i < 8; ++i) pv[i] = (row < MPR) ? (f32x4){0.f, 0.f, 0.f, 0.f} : *(const f32x4*)(p->in[I_RSH] + (size_t)b * D + 4 * (lane + 64 * i));
        }
        ss = wave_sum(ss); ps = wave_sum(ps);
        const float rs = rsqrtf(ss * (1.0f / D) + NEPS), prs = rsqrtf(ps * (1.0f / D) + NEPS);
        float* sh = (t == T - 1) ? p->out + (row < MPR ? O_SHP : O_SHS) + (size_t)b * D : nullptr;
#pragma unroll
        for (int i = 0; i < 8; ++i) {
            const int c = 4 * (lane + 64 * i);
            const f32x4 g = *(const f32x4*)(gam + c);
            f32x4 xn, xp;
#pragma unroll
            for (int j = 0; j < 4; ++j) { xn[j] = v[i][j] * rs * g[j]; xp[j] = (t > 0) ? pv[i][j] * prs * g[j] : pv[i][j]; }
            if (sh) *(f32x4*)(sh + c) = xn;
            const f32x4 xx = xp - xn;
#pragma unroll
            for (int mi = 0; mi < 6; ++mi) {
                const int msrc = (mi == 0) ? 0 : (mi == 1) ? 2 : (mi == 2) ? 3 : (mi == 3) ? 1 : mi;
                const f32x4 m4 = *(const f32x4*)(mu + (size_t)msrc * D + c);
                const f32x4 o = xn + xx * m4;
                u32x2 w; w.x = pk2(o[0], o[1]); w.y = pk2(o[2], o[3]);
                __builtin_nontemporal_store(w, (u32x2*)(a6 + (size_t)mi * MT * D + (size_t)row * D + c));
            }
        }
    }
}

struct RwkvJob { int row_base, t0, nt, hd, buf; };
DI void rwkv_prep(PP p, LAS float* vec, LAS float* bon, const RwkvJob& jb, int pt, int c8, unsigned char* ws) {
    const u16* rb = (const u16*)(ws + OFF_BIG + 6 * SZ_ACT); const u16* kbuf = rb + (size_t)MT * D; const u16* vbuf = kbuf + (size_t)MT * D;
    const float* wbuf = (const float*)(ws + OFF_BIG); const float* abuf = (const float*)(ws + OFF_BIG + 2 * SZ_ACT);
    const int hc = jb.hd * 64 + c8;
    const size_t go = (size_t)(jb.row_base + jb.t0 + (pt < jb.nt ? pt : 0)) * D + hc;
    const u32x4 r8 = *(const u32x4*)(rb + go), k8 = *(const u32x4*)(kbuf + go), v8 = *(const u32x4*)(vbuf + go);
    f32x4 wA = *(const f32x4*)(wbuf + go), wB = *(const f32x4*)(wbuf + go + 4), aA, aB; { const u32x4 a8 = *(const u32x4*)((const u16*)abuf + go); aA = (f32x4){bflo(a8.x), bfhi(a8.x), bflo(a8.y), bfhi(a8.y)}; aB = (f32x4){bflo(a8.z), bfhi(a8.z), bflo(a8.w), bfhi(a8.w)}; }
    const f32x4 kk0 = *(const f32x4*)(p->in[I_RKK] + hc), kk1 = *(const f32x4*)(p->in[I_RKK] + hc + 4);
    const f32x4 ka0 = *(const f32x4*)(p->in[I_RKA] + hc), ka1 = *(const f32x4*)(p->in[I_RKA] + hc + 4);
    const f32x4 rk0 = *(const f32x4*)(p->in[I_RRK] + hc), rk1 = *(const f32x4*)(p->in[I_RRK] + hc + 4);
    float r[8], k[8], v[8], w[8], a[8];
#pragma unroll
    for (int j = 0; j < 4; ++j) {
        r[2 * j] = bflo(r8[j]); r[2 * j + 1] = bfhi(r8[j]); k[2 * j] = bflo(k8[j]); k[2 * j + 1] = bfhi(k8[j]); v[2 * j] = bflo(v8[j]); v[2 * j + 1] = bfhi(v8[j]);
        w[j] = __expf(-__expf(-softplus(-wA[j]) - 0.5f)); w[4 + j] = __expf(-__expf(-softplus(-wB[j]) - 0.5f)); a[j] = sigm(aA[j]); a[4 + j] = sigm(aB[j]);
    }
    float kkv[8], kp[8]; float ss = 0.f, bs = 0.f, c2 = 0.f;
#pragma unroll
    for (int j = 0; j < 8; ++j) {
        const float kkw = j < 4 ? kk0[j] : kk1[j - 4], kaw = j < 4 ? ka0[j] : ka1[j - 4], rkw = j < 4 ? rk0[j] : rk1[j - 4];
        kkv[j] = k[j] * kkw; ss += kkv[j] * kkv[j];
        kp[j] = k[j] * (1.0f + (a[j] - 1.0f) * kaw);
        bs += r[j] * kp[j] * rkw; c2 += r[j] * kp[j];
    }
    ss = dpp_sum8(ss); bs = dpp_sum8(bs); c2 = dpp_sum8(c2);
    const float inv = 1.0f / fmaxf(sqrtf(ss), 1e-12f);
    LAS float* vp = vec + jb.buf * (32 * 448) + pt * 448 + c8;
    f32x4 o0, o1, b0, b1, q0, q1;
    float c1 = 0.f;
#pragma unroll
    for (int j = 0; j < 4; ++j) {
        o0[j] = kkv[j] * inv; o1[j] = kkv[4 + j] * inv; b0[j] = o0[j] * a[j]; b1[j] = o1[j] * a[4 + j];
        q0[j] = w[j] * r[j]; q1[j] = w[4 + j] * r[4 + j]; c1 += b0[j] * r[j] + b1[j] * r[4 + j];
    }
    c1 = dpp_sum8(c1);
    *(LAS f32x4*)(vp) = o0; *(LAS f32x4*)(vp + 4) = o1;
    *(LAS f32x4*)(vp + 64) = (f32x4){w[0], w[1], w[2], w[3]}; *(LAS f32x4*)(vp + 68) = (f32x4){w[4], w[5], w[6], w[7]};
    *(LAS f32x4*)(vp + 128) = b0; *(LAS f32x4*)(vp + 132) = b1;
    *(LAS f32x4*)(vp + 192) = (f32x4){kp[0], kp[1], kp[2], kp[3]}; *(LAS f32x4*)(vp + 196) = (f32x4){kp[4], kp[5], kp[6], kp[7]};
    *(LAS f32x4*)(vp + 256) = q0; *(LAS f32x4*)(vp + 260) = q1;
    *(LAS f32x4*)(vp + 320) = (f32x4){v[0], v[1], v[2], v[3]}; *(LAS f32x4*)(vp + 324) = (f32x4){v[4], v[5], v[6], v[7]};
    if (c8 == 0) { vec[jb.buf * (32 * 448) + pt * 448 + 384] = c1; vec[jb.buf * (32 * 448) + pt * 448 + 385] = c2; bon[jb.buf * 32 + pt] = bs; }
}
DI void rwkv_post(PP p, const LAS float* vec, const LAS float* ybuf, const LAS float* bon, const RwkvJob& jb, int pt, int c8, unsigned char* ws) {
    const u16* gbuf = (const u16*)(ws + OFF_BIG + 4 * SZ_ACT); u16* aout = (u16*)(ws + OFF_BIG + 5 * SZ_ACT);
    const int hc = jb.hd * 64 + c8;
    const LAS float* yp = ybuf + jb.buf * (32 * 64) + pt * 64 + c8;
    const f32x4 y0 = *(const LAS f32x4*)yp, y1 = *(const LAS f32x4*)(yp + 4);
    float sm = y0[0] + y0[1] + y0[2] + y0[3] + y1[0] + y1[1] + y1[2] + y1[3];
    sm = dpp_sum8(sm);
    const float mean = sm * (1.0f / 64.0f);
    const f32x4 d0 = y0 - mean, d1 = y1 - mean;
    float vs = d0[0] * d0[0] + d0[1] * d0[1] + d0[2] * d0[2] + d0[3] * d0[3] + d1[0] * d1[0] + d1[1] * d1[1] + d1[2] * d1[2] + d1[3] * d1[3];
    vs = dpp_sum8(vs);
    const float rstd = rsqrtf(vs * (1.0f / 64.0f) + 64e-5f);
    if (pt < jb.nt) {
        const size_t go = (size_t)(jb.row_base + jb.t0 + pt) * D + hc;
        const u32x4 g8 = *(const u32x4*)(gbuf + go);
        const f32x4 lw0 = *(const f32x4*)(p->in[I_RLNW] + hc), lw1 = *(const f32x4*)(p->in[I_RLNW] + hc + 4);
        const f32x4 lb0 = *(const f32x4*)(p->in[I_RLNB] + hc), lb1 = *(const f32x4*)(p->in[I_RLNB] + hc + 4);
        const LAS float* vp = vec + jb.buf * (32 * 448) + pt * 448 + 320 + c8;
        const f32x4 vv0 = *(const LAS f32x4*)vp, vv1 = *(const LAS f32x4*)(vp + 4);
        const float bo = bon[jb.buf * 32 + pt];
        f32x4 o0, o1;
#pragma unroll
        for (int j = 0; j < 4; ++j) { o0[j] = d0[j] * rstd * lw0[j] + lb0[j] + bo * vv0[j]; o1[j] = d1[j] * rstd * lw1[j] + lb1[j] + bo * vv1[j]; }
        u32x4 r;
        r.x = pk2(o0[0] * bflo(g8.x), o0[1] * bfhi(g8.x)); r.y = pk2(o0[2] * bflo(g8.y), o0[3] * bfhi(g8.y));
        r.z = pk2(o1[0] * bflo(g8.z), o1[1] * bfhi(g8.z)); r.w = pk2(o1[2] * bflo(g8.w), o1[3] * bfhi(g8.w));
        *(u32x4*)(aout + go) = r;
    }
}
typedef float f32x2 __attribute__((ext_vector_type(2)));
#define RSTEP_DECL(n) f32x4 n##k0, n##k1, n##w0, n##w1, n##b0, n##b1, n##p0, n##p1, n##r0, n##r1; float n##vA, n##vB; f32x2 n##cc
#define RSTEP_LOAD(n, q, qs) do { const LAS float* q_ = (q); const LAS float* qs_ = (qs); \
    n##k0 = *(const LAS f32x4*)(q_); n##k1 = *(const LAS f32x4*)(q_ + 4); n##w0 = *(const LAS f32x4*)(q_ + 64); n##w1 = *(const LAS f32x4*)(q_ + 68); \
    n##b0 = *(const LAS f32x4*)(q_ + 128); n##b1 = *(const LAS f32x4*)(q_ + 132); n##p0 = *(const LAS f32x4*)(q_ + 192); n##p1 = *(const LAS f32x4*)(q_ + 196); \
    n##r0 = *(const LAS f32x4*)(q_ + 256); n##r1 = *(const LAS f32x4*)(q_ + 260); \
    n##vA = qs_[320 + rowA]; n##vB = qs_[328 + rowA]; n##cc = *(const LAS f32x2*)(qs_ + 384); } while (0)
#define RSTEP_DO(n, yrow) rstep_do(n##k0, n##k1, n##w0, n##w1, n##b0, n##b1, n##p0, n##p1, n##r0, n##r1, n##vA, n##vB, n##cc, SA, SB, (yrow))
DI void rstep_do(const f32x4 k0, const f32x4 k1, const f32x4 w0, const f32x4 w1, const f32x4 b0, const f32x4 b1, const f32x4 p0, const f32x4 p1, const f32x4 r0, const f32x4 r1,
                 const float vA, const float vB, const f32x2 cc, f32x2 (&SA)[4], f32x2 (&SB)[4], LAS float* yrow) {
    const f32x2 kk[4] = {(f32x2){k0[0], k0[1]}, (f32x2){k0[2], k0[3]}, (f32x2){k1[0], k1[1]}, (f32x2){k1[2], k1[3]}};
    const f32x2 ww[4] = {(f32x2){w0[0], w0[1]}, (f32x2){w0[2], w0[3]}, (f32x2){w1[0], w1[1]}, (f32x2){w1[2], w1[3]}};
    const f32x2 bb[4] = {(f32x2){b0[0], b0[1]}, (f32x2){b0[2], b0[3]}, (f32x2){b1[0], b1[1]}, (f32x2){b1[2], b1[3]}};
    const f32x2 kp[4] = {(f32x2){p0[0], p0[1]}, (f32x2){p0[2], p0[3]}, (f32x2){p1[0], p1[1]}, (f32x2){p1[2], p1[3]}};
    const f32x2 wr[4] = {(f32x2){r0[0], r0[1]}, (f32x2){r0[2], r0[3]}, (f32x2){r1[0], r1[1]}, (f32x2){r1[2], r1[3]}};
    f32x2 a1 = SA[0] * kk[0], a2 = SA[0] * wr[0], c1 = SB[0] * kk[0], c2 = SB[0] * wr[0];
#pragma unroll
    for (int i = 1; i < 4; ++i) { a1 += SA[i] * kk[i]; a2 += SA[i] * wr[i]; c1 += SB[i] * kk[i]; c2 += SB[i] * wr[i]; }
    const float P1A = dpp_sum8(a1.x + a1.y), P1B = dpp_sum8(c1.x + c1.y);
#pragma unroll
    for (int i = 0; i < 4; ++i) {
        SA[i] = SA[i] * ww[i] + (kp[i] * vA - bb[i] * P1A);
        SB[i] = SB[i] * ww[i] + (kp[i] * vB - bb[i] * P1B);
    }
    const float P2A = dpp_sum8(a2.x + a2.y), P2B = dpp_sum8(c2.x + c2.y);
    yrow[0] = P2A - P1A * cc.x + vA * cc.y;
    yrow[8] = P2B - P1B * cc.x + vB * cc.y;
}
__device__ __forceinline__ void rwkv_scan(PP p, LAS unsigned char* lds, const int wv) {
    const int tid = opaque_tid(wv), wid = wv, lane = tid & 63;
    LAS float* vec = (LAS float*)lds;
    LAS float* ybuf = (LAS float*)(lds + 114688);
    LAS float* bon = (LAS float*)(lds + 131072);
    unsigned char* ws = p->ws;
    const bool scanw = wid < 4;
    const int rg = lane >> 3, kq = lane & 7, rowA = 16 * (wid & 3) + rg;
    const int htid = tid & 255, pt = htid >> 3, c8 = (htid & 7) * 8;
    const int G = gridDim.x;
    int u, ustep, uend = 128 + 4096;
    if (G >= 256) { if ((int)blockIdx.x < 128) { u = blockIdx.x; ustep = 1 << 30; uend = 128; } else { u = 128 + (blockIdx.x - 128); ustep = G - 128; } }
    else { u = blockIdx.x; ustep = G; }
    RwkvJob pend; pend.nt = 0; pend.row_base = 0; pend.t0 = 0; pend.hd = 0; pend.buf = 0;
    for (; u < uend; u += ustep) {
        const bool pr = u < 128; int b, hd, row_base, T;
        if (pr) { b = u >> 5; hd = u & 31; row_base = b * 2048; T = 2048; } else { const int s = u - 128; b = s >> 5; hd = s & 31; row_base = MPR + b * 8; T = 8; }
        const int nb = (T + 31) >> 5;
        const size_t sofs = (size_t)(b * 32 + hd) * 4096 + rowA * 64 + 8 * kq;
        f32x2 SA[4], SB[4];
        if (scanw) {
            if (pr) {
#pragma unroll
                for (int j = 0; j < 4; ++j) { SA[j] = (f32x2){0.f, 0.f}; SB[j] = (f32x2){0.f, 0.f}; }
            } else {
                const f32x4 a0 = *(const f32x4*)(p->in[I_RS] + sofs), a1 = *(const f32x4*)(p->in[I_RS] + sofs + 4);
                const f32x4 b0 = *(const f32x4*)(p->in[I_RS] + sofs + 512), b1 = *(const f32x4*)(p->in[I_RS] + sofs + 516);
                SA[0] = (f32x2){a0[0], a0[1]}; SA[1] = (f32x2){a0[2], a0[3]}; SA[2] = (f32x2){a1[0], a1[1]}; SA[3] = (f32x2){a1[2], a1[3]};
                SB[0] = (f32x2){b0[0], b0[1]}; SB[1] = (f32x2){b0[2], b0[3]}; SB[2] = (f32x2){b1[0], b1[1]}; SB[3] = (f32x2){b1[2], b1[3]};
            }
        } else {
            if (pend.nt > 0) rwkv_post(p, vec, ybuf, bon, pend, pt, c8, ws);
            RwkvJob jb; jb.row_base = row_base; jb.t0 = 0; jb.nt = T < 32 ? T : 32; jb.hd = hd; jb.buf = 0;
            rwkv_prep(p, vec, bon, jb, pt, c8, ws);
        }
        __syncthreads();
        for (int j = 0; j < nb; ++j) {
            const int t0 = j * 32, nt = (T - t0) < 32 ? (T - t0) : 32;
            if (scanw) {
                const LAS float* vt = vec + (j & 1) * (32 * 448) + 8 * kq;
                LAS float* yb = ybuf + (j & 1) * (32 * 64);
                const LAS float* vs0 = vec + (j & 1) * (32 * 448);
                RSTEP_DECL(s0); RSTEP_DECL(s1); RSTEP_LOAD(s0, vt, vs0);
                for (int t = 0; t < nt; t += 4) {
                    const LAS float* vtb = vt + t * 448; const LAS float* vsb = vs0 + t * 448; LAS float* ybb = yb + t * 64 + rowA;
                    RSTEP_LOAD(s1, vtb + 448, vsb + 448);
                    RSTEP_DO(s0, ybb);
                    RSTEP_LOAD(s0, vtb + 2 * 448, vsb + 2 * 448);
                    RSTEP_DO(s1, ybb + 64);
                    RSTEP_LOAD(s1, vtb + 3 * 448, vsb + 3 * 448);
                    RSTEP_DO(s0, ybb + 128);
                    const int tn = (t + 4 < nt) ? 4 : 3;
                    RSTEP_LOAD(s0, vtb + tn * 448, vsb + tn * 448);
                    RSTEP_DO(s1, ybb + 192);
                }
            } else {
                if (j >= 1) { RwkvJob jp; jp.row_base = row_base; jp.t0 = t0 - 32; jp.nt = 32; jp.hd = hd; jp.buf = (j - 1) & 1; rwkv_post(p, vec, ybuf, bon, jp, pt, c8, ws); }
                if (j + 1 < nb) { RwkvJob jn; jn.row_base = row_base; jn.t0 = t0 + 32; jn.nt = (T - t0 - 32) < 32 ? (T - t0 - 32) : 32; jn.hd = hd; jn.buf = (j + 1) & 1; rwkv_prep(p, vec, bon, jn, pt, c8, ws); }
            }
            __syncthreads();
        }
        pend.row_base = row_base; pend.t0 = (nb - 1) * 32; pend.nt = T - (nb - 1) * 32; pend.hd = hd; pend.buf = (nb - 1) & 1;
        if (scanw) {
            float* So = p->out + (pr ? O_SP : O_SS) + sofs;
            __builtin_nontemporal_store((f32x4){SA[0].x, SA[0].y, SA[1].x, SA[1].y}, (f32x4*)So); __builtin_nontemporal_store((f32x4){SA[2].x, SA[2].y, SA[3].x, SA[3].y}, (f32x4*)(So + 4));
            __builtin_nontemporal_store((f32x4){SB[0].x, SB[0].y, SB[1].x, SB[1].y}, (f32x4*)(So + 512)); __builtin_nontemporal_store((f32x4){SB[2].x, SB[2].y, SB[3].x, SB[3].y}, (f32x4*)(So + 516));
        }
    }
    if (!scanw && pend.nt > 0) rwkv_post(p, vec, ybuf, bon, pend, pt, c8, ws);
    __syncthreads();
}

__device__ __forceinline__ void final_norm(PP p, const int wv) {
    const u16* h = (const u16*)(p->ws + OFF_H); const float* ssq = (const float*)(p->ws + OFF_SSQ) + 4 * MT; const float* g = p->in[I_NFIN];
    const int n4 = MT * D / 4;
    const int tid = opaque_tid(wv);
    for (int i = blockIdx.x * 512 + tid; i < n4; i += gridDim.x * 512) {
        const int row = i >> 9, c = (i & 511) * 4;
        const float rs = rsqrtf(ssq[row] * (1.0f / D) + NEPS);
        const f32x4 v = ld_bf16x4(h + (size_t)i * 4), gg = *(const f32x4*)(g + c);
        __builtin_nontemporal_store(v * rs * gg, (f32x4*)(p->out + O_Y + (size_t)i * 4));
    }
}

DI unsigned xcc_id() { return (unsigned)__builtin_amdgcn_s_getreg(20 | (3 << 11)) & 7u; }
DI void grid_bar(unsigned* ctl, const unsigned epoch, const unsigned nx, const unsigned nxcc, const int wv) {
    typedef __attribute__((address_space(1))) unsigned gu32;
    __syncthreads();
    if (opaque_tid(wv) == 0) {
        const unsigned x = xcc_id();
        const unsigned old = __hip_atomic_fetch_add((gu32*)(ctl + 64 * x), 1u, __ATOMIC_RELAXED, __HIP_MEMORY_SCOPE_AGENT);
        if (old + 1u == nx * epoch) {
            __builtin_amdgcn_fence(__ATOMIC_RELEASE, "agent");
            asm volatile("s_waitcnt vmcnt(0)" ::: "memory");
            __hip_atomic_fetch_add((gu32*)(ctl + 512), 1u, __ATOMIC_RELAXED, __HIP_MEMORY_SCOPE_AGENT);
            while (__hip_atomic_load((gu32*)(ctl + 512), __ATOMIC_RELAXED, __HIP_MEMORY_SCOPE_AGENT) < nxcc * epoch) __builtin_amdgcn_s_sleep(1);
            __hip_atomic_store((gu32*)(ctl + 640 + 16 * x), epoch, __ATOMIC_RELAXED, __HIP_MEMORY_SCOPE_AGENT);
        } else {
            while (__hip_atomic_load((gu32*)(ctl + 640 + 16 * x), __ATOMIC_RELAXED, __HIP_MEMORY_SCOPE_AGENT) < epoch) __builtin_amdgcn_s_sleep(1);
        }
        __builtin_amdgcn_fence(__ATOMIC_ACQUIRE, "agent");
        asm volatile("s_waitcnt vmcnt(0)" ::: "memory");
    }
    __syncthreads();
}
#ifndef EN_MASK
#define EN_MASK 0xFFFF
#endif
#define EN(k) ((EN_MASK >> (k)) & 1)
#ifndef DUP_MASK
#define DUP_MASK 0
#endif
#define DUP(k) ((DUP_MASK >> (k)) & 1)
__global__ void __launch_bounds__(512, 2) mega(Params p_unused) {
    const PP kp = (PP)__builtin_amdgcn_kernarg_segment_ptr();
    const int wv = __builtin_amdgcn_readfirstlane((int)(threadIdx.x >> 6));
    extern __shared__ __attribute__((aligned(16))) unsigned char smem_raw[];
    LAS unsigned char* lds = (LAS unsigned char*)smem_raw;
    cg::grid_group grid = cg::this_grid();
    const int G = gridDim.x, cid = blockIdx.x;
    const int ph_lo = kp->ph_lo, ph_hi = kp->ph_hi;
    int ph = 0; unsigned nbar = 0, nx_ = 1, nxcc_ = 1;
    if (opaque_tid(wv) == 0) { typedef __attribute__((address_space(1))) unsigned gu32; __hip_atomic_fetch_add((gu32*)((unsigned*)(kp->ws + OFF_CNT) + 576 + xcc_id()), 1u, __ATOMIC_RELAXED, __HIP_MEMORY_SCOPE_AGENT); }
#define PHASE_BEGIN if (ph >= ph_lo && ph < ph_hi) { const PP p = launder(kp); unsigned char* ws = p->ws; u16* h = (u16*)(ws + OFF_H); float* ssq = (float*)(ws + OFF_SSQ); const char* big = (const char*)(ws + OFF_BIG); (void)h; (void)ssq; (void)big;
#define PHASE_END   } ++ph; if (ph > ph_lo && ph < ph_hi) { ++nbar; grid_bar((unsigned*)(kp->ws + OFF_CNT), nbar, nx_, nxcc_, wv); }
#define PHASE_END_CG } ++ph; if (ph > ph_lo && ph < ph_hi) { grid.sync(); \
        { typedef __attribute__((address_space(1))) unsigned gu32; gu32* cen = (gu32*)((unsigned*)(kp->ws + OFF_CNT) + 576); nxcc_ = 0; \
          for (int x_ = 0; x_ < 8; ++x_) nxcc_ += (__hip_atomic_load(cen + x_, __ATOMIC_RELAXED, __HIP_MEMORY_SCOPE_AGENT) != 0u) ? 1u : 0u; \
          nx_ = __hip_atomic_load(cen + xcc_id(), __ATOMIC_RELAXED, __HIP_MEMORY_SCOPE_AGENT); nx_ = (unsigned)__builtin_amdgcn_readfirstlane((int)nx_); nxcc_ = (unsigned)__builtin_amdgcn_readfirstlane((int)nxcc_); } }

    PHASE_BEGIN { int nrep = DUP(0) ? 2 : 1; asm volatile("" : "+s"(nrep)); for (int rep = 0; rep < nrep; ++rep) { if (EN(0)) phase0(p, lds, wv); __syncthreads(); } } PHASE_END_CG
    PHASE_BEGIN
    {
        pg8::MultiOrder<pg8::Sub1> S; S.sub = {big, (const char*)(ws + OFF_W_IN0), 25}; S.K = D; S.nM = MT / 256; S.G = G; S.c = cid;
        EpiMlstmIn E{(u16*)(ws + OFF_BIG + SZ_ACT), (u16*)(ws + OFF_BIG + SZ_ACT + SZ_ACT / 2), (u16*)(ws + OFF_BIG + 2 * SZ_ACT), (u16*)(ws + OFF_BIG + 3 * SZ_ACT),
                     (float*)(ws + OFF_LG), (float*)(ws + OFF_LG) + (size_t)MT * 8, p->in[I_MBIG], p->in[I_MBFG]};
        if (EN(1)) pg8::gemm_phase(lds, D, S, E, wv);
        pg8::MultiOrder<pg8::Sub1> S2; S2.sub = {(const char*)(ws + OFF_AP), (const char*)(ws + OFF_W_PP), 8}; S2.K = 256; S2.nM = MT / 256; S2.G = G; S2.c = (cid + 132) % G;
        EpiLora2 E2{nullptr, nullptr, nullptr, (u16*)(ws + OFF_PPB), nullptr, nullptr, 3};
        int K2 = 256; asm volatile("" : "+s"(K2)); S2.K = K2;
        if (EN(2)) pg8::gemm_phase(lds, K2, S2, E2, wv);
    }
    PHASE_END
    PHASE_BEGIN { int nrep = DUP(3) ? 2 : 1; asm volatile("" : "+s"(nrep)); for (int rep = 0; rep < nrep; ++rep) { if (EN(3)) mlstm_scan(p, lds, wv); __syncthreads(); } { int rank, nb; if (G > 64) { rank = cid - 32; nb = G - 32; } else { rank = cid; nb = G; } if (rank >= 0) convert_group(p, lds, wv, 1, rank, nb); } } PHASE_END
#pragma unroll 1
    for (int layer = 0; layer < 2; ++layer) {
        if (layer == 1) {
            PHASE_BEGIN if (EN(4)) rwkv_norm_mix(p, wv); PHASE_END
            PHASE_BEGIN
            {
                pg8::MultiOrder<pg8::SubRwkvIn> S; S.sub = {big, (const char*)(ws + OFF_W_IN1)};
                S.K = D; S.nM = MT / 256; S.G = G; S.c = cid;
                EpiRwkvIn E{(u16*)(ws + OFF_BIG + 6 * SZ_ACT), (u16*)(ws + OFF_LORA)};
                if (EN(5)) pg8::gemm_phase(lds, D, S, E, wv);
            }
            PHASE_END
            PHASE_BEGIN
            {
                pg8::MultiOrder<pg8::SubLora2> S; S.sub = {(const char*)(ws + OFF_LORA), (const char*)(ws + OFF_W_L2), (const char*)(ws + OFF_AP) + (size_t)MT * 512, (const char*)(ws + OFF_W_PP + SZ_W_PP)};
                S.K = 256; S.nM = MT / 256; S.G = G; S.c = cid;
                EpiLora2 E{(float*)(ws + OFF_BIG), (float*)(ws + OFF_BIG + 2 * SZ_ACT), (u16*)(ws + OFF_BIG + 4 * SZ_ACT), (u16*)(ws + OFF_PPB), p->in[I_RW0], p->in[I_RA0], 0};
                int K2 = 256; asm volatile("" : "+s"(K2)); S.K = K2;
                if (EN(6)) pg8::gemm_phase(lds, K2, S, E, wv);
            }
            PHASE_END
            PHASE_BEGIN { int nrep = DUP(7) ? 2 : 1; asm volatile("" : "+s"(nrep)); for (int rep = 0; rep < nrep; ++rep) { if (EN(7)) rwkv_scan(p, lds, wv); __syncthreads(); } { int rank, nb; if (G >= 256) { rank = cid - 128; nb = G - 128; } else { rank = cid; nb = G; } if (rank >= 0) convert_group(p, lds, wv, 2, rank, nb); } } PHASE_END
        }
#pragma unroll 1
        for (int r = 0; r < 2; ++r) {
            PHASE_BEGIN
            {
                pg8::SplitOrder S; S.G = G; S.c = cid; S.part = (float*)(ws + OFF_BIG + 6 * SZ_ACT); S.cnt = (unsigned*)(ws + OFF_CNT);
                int K;
                if (r == 0) { S.A = big + 5 * SZ_ACT; S.B = (const char*)(ws + (layer ? OFF_W_OUT1 : OFF_W_OUT0)); K = D; S.nsp = -1; }
                else { S.A = big + SZ_ACT; S.B = (const char*)(ws + OFF_W_DN + layer * SZ_W_DN); K = DFF; S.nsp = -1; }
                S.K = K;
                EpiResid E{h, ssq + (size_t)(layer * 2 + r) * MT, (r == 0 ? p->in[I_NFFN] : p->in[I_NPLE]) + layer * D, (u16*)(ws + OFF_BIG + (r == 0 ? 0 : 5 * SZ_ACT))};
                if (EN(8)) pg8::gemm_phase(lds, K, S, E, wv);
                {
                    EpiResidS ES{h, ssq + (size_t)(layer * 2 + r) * MT, (r == 0 ? p->in[I_NFFN] : p->in[I_NPLE]) + layer * D, (u16*)(ws + OFF_BIG + (r == 0 ? 0 : 5 * SZ_ACT))};
                    sgemm_sample(lds, (const u16*)S.A + (size_t)MPR * K, (const u16*)S.B, K, ES, wv);
                }
            }
            PHASE_END
            if (r == 0) {
                PHASE_BEGIN
                {
                    pg8::MultiOrder<pg8::Sub1> S; S.sub = {big, (const char*)(ws + OFF_W_GU + layer * SZ_W_GU), 44}; S.K = D; S.nM = MT / 256; S.G = G; S.c = cid; S.Lmax = 1536;
                    EpiSwiglu E{ssq + (size_t)(layer * 2) * MT, (u16*)(ws + OFF_BIG + SZ_ACT)};
                    if (EN(9)) pg8::gemm_phase(lds, D, S, E, wv);
                    for (int q = cid; q < 192; q += G) {
                        pg8::Unit uq; S.unit_at(1536 + (q >> 2), uq);
                        sgemm_swiglu_tile(lds, (const u16*)big, (const u16*)(ws + OFF_W_GU + layer * SZ_W_GU), ssq + (size_t)(layer * 2) * MT, (u16*)(ws + OFF_BIG + SZ_ACT), wv, uq.pm * 256 + ((q >> 1) & 1) * 128, uq.pn * 128 + (q & 1) * 64);
                    }
                }
                PHASE_END
            }
        }
        PHASE_BEGIN
        {
            pg8::SplitOrder S; S.G = G; S.c = cid; S.part = (float*)(ws + OFF_BIG + 6 * SZ_ACT); S.cnt = (unsigned*)(ws + OFF_CNT); S.A = big + 5 * SZ_ACT; S.B = (const char*)(ws + OFF_W_PG + layer * SZ_SQ); S.K = D; S.nsp = -1;
            EpiPle E{ssq + (size_t)(layer * 2 + 1) * MT, (const u16*)(ws + OFF_PPB), h, layer ? ssq + 4 * MT : nullptr};
            if (EN(10)) pg8::gemm_phase(lds, D, S, E, wv);
            {
                EpiPleS ES{ssq + (size_t)(layer * 2 + 1) * MT, (const u16*)(ws + OFF_PPB), h, layer ? ssq + 4 * MT : nullptr};
                sgemm_sample(lds, (const u16*)S.A + (size_t)MPR * D, (const u16*)S.B, D, ES, wv);
            }
        }
        PHASE_END
    }
    PHASE_BEGIN if (EN(11)) final_norm(p, wv); PHASE_END
}

extern "C" void kernel_launch(void* const* d_in, const int* in_sizes, int n_in, void* d_out, int out_size, void* d_ws, size_t ws_size, hipStream_t stream) {
    static int grid = 0;
    if (!grid) {
        int dev = 0, cus = 0, per_cu = 0;
        hipGetDevice(&dev);
        hipDeviceGetAttribute(&cus, hipDeviceAttributeMultiprocessorCount, dev);
        hipFuncSetAttribute((const void*)mega, hipFuncAttributeMaxDynamicSharedMemorySize, LDS_BYTES);
        hipOccupancyMaxActiveBlocksPerMultiprocessor(&per_cu, (const void*)mega, 512, LDS_BYTES);
        if (per_cu < 1) per_cu = 1;
        grid = cus * per_cu;
        if (ws_size < WS_NEED) fprintf(stderr, "kernel_launch: workspace too small: %zu < %zu\n", ws_size, (size_t)WS_NEED);
        if (n_in != N_IN) fprintf(stderr, "kernel_launch: expected %d inputs, got %d\n", (int)N_IN, n_in);
    }
    Params p{};
    for (int i = 0; i < N_IN; ++i) p.in[i] = (const float*)d_in[i];
    p.out = (float*)d_out; p.ws = (unsigned char*)d_ws; p.ph_lo = 0; p.ph_hi = NPH;
    (void)hipMemsetAsync((char*)d_ws + OFF_CNT, 0, 4096, stream);
    void* args[] = {&p};
    hipError_t e = hipLaunchCooperativeKernel((const void*)mega, dim3(grid), dim3(512), args, LDS_BYTES, stream);
    if (e != hipSuccess) fprintf(stderr, "cooperative launch failed: %s (grid %d)\n", hipGetErrorString(e), grid);
}
```
